# Optimizing an MI355X kernel written in HIP

```python
import math
import jax, jax.numpy as jnp
from jax import lax
import numpy as np

D_MODEL = 2048
BATCH = 8
SEQ = 2048
DEPTH = 1

ATTN_HEADS = 16
HEAD_DIM = 128
ATTN_W = ATTN_HEADS * HEAD_DIM
DILATED_GROUPS = ((128, 1), (512, 4), (2048, 16))
BLK = 128
LRU_W = D_MODEL
LRU_HEADS = 16
LRU_BLK = LRU_W // LRU_HEADS
CONV_W = 4
LRU_C = 8.0
D_FF = 4 * D_MODEL
EPS = 1e-6
IN_SPLITS = (ATTN_W, ATTN_W, ATTN_W, LRU_W, LRU_W, D_MODEL, D_MODEL)
IN_COLS = sum(IN_SPLITS)

kernel_name = "hybrid_dilated_attn_rglru_gated_block"


def rms_norm(x, g):
    xf = x.astype(jnp.float32)
    y = xf * lax.rsqrt(jnp.mean(xf * xf, axis=-1, keepdims=True) + EPS)
    return (y * g.astype(jnp.float32)).astype(x.dtype)


def alibi_slopes(n_heads):
    return 2.0 ** (-8.0 * jnp.arange(1, n_heads + 1, dtype=jnp.float32) / n_heads)


def dilated_group_attention(q, k, v, slopes, window, dilation):
    b, s, h, dh = q.shape
    d = dilation
    span = window // d
    u_len = s // d
    n_blk = -(-u_len // BLK)
    u_pad = n_blk * BLK
    qs = q.reshape(b, u_len, d, h, dh)
    ks = k.reshape(b, u_len, d, h, dh)
    vs = v.reshape(b, u_len, d, h, dh)
    qb = jnp.pad(qs, ((0, 0), (0, u_pad - u_len), (0, 0), (0, 0), (0, 0))).reshape(b, n_blk, BLK, d, h, dh)
    pad_kv = ((0, 0), (BLK, u_pad - u_len), (0, 0), (0, 0), (0, 0))
    kp = jnp.pad(ks, pad_kv).reshape(b, n_blk + 1, BLK, d, h, dh)
    vp = jnp.pad(vs, pad_kv).reshape(b, n_blk + 1, BLK, d, h, dh)
    kwin = jnp.concatenate([kp[:, :-1], kp[:, 1:]], axis=2)
    vwin = jnp.concatenate([vp[:, :-1], vp[:, 1:]], axis=2)
    scores = jnp.einsum('bnqrhe,bnkrhe->bnrhqk', qb, kwin).astype(jnp.float32) * (HEAD_DIM ** -0.5)
    i = jnp.arange(BLK)[:, None]
    j = jnp.arange(2 * BLK)[None, :]
    diff = BLK + i - j
    band = (diff >= 0) & (diff <= span)
    n_idx = jnp.arange(n_blk)[:, None, None]
    valid = band[None] & ((n_idx - 1) * BLK + j[None] >= 0)
    bias = -(slopes * d)[:, None, None] * diff.astype(jnp.float32)[None]
    scores = scores + bias[None, None, None]
    scores = jnp.where(valid[None, :, None, None], scores, -jnp.inf)
    m = jnp.max(scores, axis=-1, keepdims=True)
    p = jnp.exp(scores - m)
    l = jnp.sum(p, axis=-1)
    o = jnp.einsum('bnrhqk,bnkrhe->bnqrhe', p.astype(v.dtype), vwin).astype(jnp.float32)
    l_t = jnp.transpose(l, (0, 1, 4, 2, 3))
    o = o / l_t[..., None]
    lse = jnp.transpose(m[..., 0] + jnp.log(l), (0, 1, 4, 2, 3))
    o = o.reshape(b, u_pad, d, h, dh)[:, :u_len].reshape(b, s, h, dh)
    lse = lse.reshape(b, u_pad, d, h)[:, :u_len].reshape(b, s, h)
    return o, lse


def dilated_attention(q, k, v):
    b, s, _ = q.shape
    q = q.reshape(b, s, ATTN_HEADS, HEAD_DIM)
    k = k.reshape(b, s, ATTN_HEADS, HEAD_DIM)
    v = v.reshape(b, s, ATTN_HEADS, HEAD_DIM)
    slopes = alibi_slopes(ATTN_HEADS)
    outs, lses = [], []
    for window, dilation in DILATED_GROUPS:
        o, lse = dilated_group_attention(q, k, v, slopes, window, dilation)
        outs.append(o)
        lses.append(lse)
    w = jax.nn.softmax(jnp.stack(lses, axis=0), axis=0)
    out = jnp.sum(w[..., None] * jnp.stack(outs, axis=0), axis=0)
    return out.reshape(b, s, ATTN_W).astype(q.dtype)


def rg_lru_branch(xr, gate, conv_w, conv_b, wa, ba, wx, bx, lam):
    b, s, c = xr.shape
    xc = lax.conv_general_dilated(
        xr, conv_w.reshape(CONV_W, 1, c).astype(xr.dtype), window_strides=(1,),
        padding=[(CONV_W - 1, 0)], dimension_numbers=('NWC', 'WIO', 'NWC'),
        feature_group_count=c) + conv_b
    xh = xc.reshape(b, s, LRU_HEADS, LRU_BLK)
    r = jax.nn.sigmoid((jnp.einsum('bshi,hij->bshj', xh, wa).reshape(b, s, c) + ba).astype(jnp.float32))
    ig = jax.nn.sigmoid((jnp.einsum('bshi,hij->bshj', xh, wx).reshape(b, s, c) + bx).astype(jnp.float32))
    log_a = -LRU_C * r * jax.nn.softplus(-lam.astype(jnp.float32))
    a = jnp.exp(log_a)
    mult = jnp.sqrt(-jnp.expm1(2.0 * log_a))
    u = mult * (ig * xc.astype(jnp.float32))

    def combine(c1, c2):
        a1, b1 = c1
        a2, b2 = c2
        return a1 * a2, a2 * b1 + b2

    _, hseq = lax.associative_scan(combine, (a, u), axis=1)
    return (hseq * jax.nn.gelu(gate.astype(jnp.float32))).astype(xr.dtype)


def setup_inputs(seed: int = 0) -> dict:
    key = jax.random.key(seed)
    ks = jax.random.split(key, 20)
    f32 = jnp.float32
    nrm = lambda k, shape, scale: jax.random.normal(k, shape, f32) * scale
    a8 = jax.random.uniform(ks[9], (DEPTH, LRU_W), f32, 0.9, 0.999)
    a_base = a8 ** (1.0 / LRU_C)
    lru_lambda = jnp.log(a_base) - jnp.log1p(-a_base)
    return {
        "x": jax.random.normal(ks[0], (BATCH, SEQ, D_MODEL), f32),
        "norm_mix_g": 1.0 + nrm(ks[1], (DEPTH, D_MODEL), 0.02),
        "w_in": nrm(ks[2], (DEPTH, D_MODEL, IN_COLS), D_MODEL ** -0.5),
        "conv_w": nrm(ks[3], (DEPTH, CONV_W, LRU_W), CONV_W ** -0.5),
        "conv_b": nrm(ks[4], (DEPTH, LRU_W), 0.02),
        "lru_wa": nrm(ks[5], (DEPTH, LRU_HEADS, LRU_BLK, LRU_BLK), LRU_BLK ** -0.5),
        "lru_ba": nrm(ks[6], (DEPTH, LRU_W), 0.02),
        "lru_wx": nrm(ks[7], (DEPTH, LRU_HEADS, LRU_BLK, LRU_BLK), LRU_BLK ** -0.5),
        "lru_bx": nrm(ks[8], (DEPTH, LRU_W), 0.02),
        "lru_lambda": lru_lambda,
        "w_proj_attn": nrm(ks[10], (DEPTH, ATTN_W, D_MODEL), ATTN_W ** -0.5),
        "w_proj_lru": nrm(ks[11], (DEPTH, LRU_W, D_MODEL), LRU_W ** -0.5),
        "w_out": nrm(ks[12], (DEPTH, D_MODEL, D_MODEL), D_MODEL ** -0.5),
        "norm_mlp_g": 1.0 + nrm(ks[13], (DEPTH, D_MODEL), 0.02),
        "w_up": nrm(ks[14], (DEPTH, D_MODEL, D_FF), D_MODEL ** -0.5),
        "w_down": nrm(ks[15], (DEPTH, D_FF, D_MODEL), D_FF ** -0.5),
        "norm_final_g": 1.0 + nrm(ks[16], (D_MODEL,), 0.02),
    }


def reference(x, norm_mix_g, w_in, conv_w, conv_b, lru_wa, lru_ba, lru_wx, lru_bx, lru_lambda,
              w_proj_attn, w_proj_lru, w_out, norm_mlp_g, w_up, w_down, norm_final_g):
    h = x
    split_idx = list(np.cumsum(IN_SPLITS)[:-1])
    for l in range(DEPTH):
        xn = rms_norm(h, norm_mix_g[l])
        proj = jnp.einsum('bsd,dc->bsc', xn, w_in[l])
        q, k, v, xr, xg, g_attn, g_lru = jnp.split(proj, split_idx, axis=-1)
        y_attn = dilated_attention(q, k, v)
        y_lru = rg_lru_branch(xr, xg, conv_w[l], conv_b[l], lru_wa[l], lru_ba[l],
                              lru_wx[l], lru_bx[l], lru_lambda[l])
        merged = (jax.nn.sigmoid(g_attn) * jnp.einsum('bsc,cd->bsd', y_attn, w_proj_attn[l])
                  + jax.nn.sigmoid(g_lru) * jnp.einsum('bsc,cd->bsd', y_lru, w_proj_lru[l]))
        h = h + jnp.einsum('bsd,de->bse', merged, w_out[l])
        hn = rms_norm(h, norm_mlp_g[l])
        hid = jnp.square(jax.nn.relu(jnp.einsum('bsd,df->bsf', hn, w_up[l])))
        h = h + jnp.einsum('bsf,fd->bsd', hid, w_down[l])
    return rms_norm(h, norm_final_g)
```

```cpp
#include <hip/hip_runtime.h>
#include <cstdio>
#include <cstdint>
#include <cmath>
#include <hip/hip_cooperative_groups.h>
namespace cg = cooperative_groups;
namespace pg8 {
#define PG8_LAS __attribute__((address_space(3)))
typedef unsigned short bf16_t;
typedef short bf16x8 __attribute__((ext_vector_type(8)));
typedef float f32x4 __attribute__((ext_vector_type(4)));
typedef unsigned u32x4 __attribute__((ext_vector_type(4)));
constexpr int BM = 256, BK = 64, HALF = 128, HTB = HALF * BK * 2  , STAGE_BYTES = 8 * HTB, NXCD = 8, WGM = 8;

__host__ __device__ __forceinline__ int lds_byte(int r, int c) { const int st = (r >> 4) * 2 + (c >> 5), rr = r & 15, cc = c & 31, ob = rr * 64 + cc * 2; return st * 1024 + (ob ^ (((ob >> 9) & 1) << 5)); }
__host__ __device__ __forceinline__ void stage_rc(int b, int& R, int& C) { const int st = b / 1024, sb = b % 1024, swz = sb ^ (((sb >> 9) & 1) << 5); R = (st >> 1) * 16 + swz / 64; C = (st & 1) * 32 + (swz % 64) / 2; }
__host__ __device__ __forceinline__ int perm32(int rho) { const int n = rho >> 4, i = rho & 15; return 8 * (i >> 2) + 4 * n + (i & 3); }

struct Unit { int pm, pn; };
struct Gemm { const bf16_t* A; const bf16_t* Bt; int M, N, K, lda, kdir; };

struct StaticOrder {
    int nM, nN, nwg, G, c;
    __host__ __device__ void init(int M, int N, int G_, int c_) { nM = M / BM; nN = N / BM; nwg = nM * nN; G = G_; c = c_; }
    __host__ __device__ bool next(int i, Unit& u) const {
        const long L = (long)i * G + c; if (L >= nwg) return false;
        int wgid = (int)L; { const int q = nwg / NXCD, r = nwg % NXCD, xcd = wgid % NXCD, off = wgid / NXCD; wgid = (xcd < r ? xcd * (q + 1) : r * (q + 1) + (xcd - r) * q) + off; }
        const int nig = WGM * nN, gid = wgid / nig, fm = gid * WGM, gsz = (nM - fm) < WGM ? (nM - fm) : WGM;
        u.pm = fm + ((wgid % nig) % gsz); u.pn = (wgid % nig) / gsz; return true;
    }
    __device__ __forceinline__ void a_ready(const Unit&) const {}
    __device__ __forceinline__ void done(const Unit&) const {}
};
__device__ __forceinline__ unsigned cvt_pk_bf16(float lo, float hi) { unsigned r; asm volatile("v_cvt_pk_bf16_f32 %0, %1, %2" : "=v"(r) : "v"(lo), "v"(hi)); return r; }
typedef float f32x2 __attribute__((ext_vector_type(2)));
typedef unsigned u32x2 __attribute__((ext_vector_type(2)));
__device__ __forceinline__ float bf_lo(unsigned w) { return __uint_as_float(w << 16); }
__device__ __forceinline__ float bf_hi(unsigned w) { return __uint_as_float(w & 0xffff0000u); }
__device__ __forceinline__ float fsigmoid(float x) { return __builtin_amdgcn_rcpf(1.0f + __builtin_amdgcn_exp2f(-1.4426950408889634f * x)); }
__device__ __forceinline__ float fgelu(float x) { const float z = x * (1.0f + 0.044715f * x * x); return x * __builtin_amdgcn_rcpf(1.0f + __builtin_amdgcn_exp2f(-2.0f * 0.7978845608028654f * 1.4426950408889634f * z)); }
constexpr size_t SEG_ELEMS = (size_t)16384 * 2048;

struct EpiProj {
    static constexpr bool PERM = true, AFTER_DRAIN = false;
    bf16_t* seg03; bf16_t* xg; bf16_t* gates; float qscale;
    __device__ __forceinline__ void operator()(const f32x4 (&acc)[2][2][4][2], const Unit& u, int wr, int wc, int fr, int fq) const {
        const int seg = u.pn >> 3, colt = (u.pn & 7) * BM;
        bf16_t* base; int ldc;
        if (seg < 4) { base = seg03 + (size_t)seg * SEG_ELEMS; ldc = 2048; } else if (seg == 4) { base = xg; ldc = 4096; } else { base = gates + (size_t)(seg - 5) * SEG_ELEMS; ldc = 2048; }
        const float sc = (seg == 0) ? qscale : 1.f; const bool sig = seg >= 5, gel = seg == 4;
        const int row0 = u.pm * BM + wr * 64 + fr, col0 = colt + wc * 32 + 8 * fq;
#pragma unroll
        for (int ai = 0; ai < 2; ++ai)
#pragma unroll
            for (int m = 0; m < 4; ++m) { bf16_t* rowp = base + (size_t)(row0 + ai * HALF + m * 16) * ldc + col0;
#pragma unroll
                for (int bj = 0; bj < 2; ++bj) { f32x4 v0 = acc[ai][bj][m][0], v1 = acc[ai][bj][m][1];
                    if (sig) {
#pragma unroll
                        for (int e = 0; e < 4; ++e) { v0[e] = fsigmoid(v0[e]); v1[e] = fsigmoid(v1[e]); } }
                    else if (gel) {
#pragma unroll
                        for (int e = 0; e < 4; ++e) { v0[e] = fgelu(v0[e]); v1[e] = fgelu(v1[e]); } }
                    else { v0 = v0 * sc; v1 = v1 * sc; }
                    u32x4 w; w.x = cvt_pk_bf16(v0[0], v0[1]); w.y = cvt_pk_bf16(v0[2], v0[3]); w.z = cvt_pk_bf16(v1[0], v1[1]); w.w = cvt_pk_bf16(v1[2], v1[3]);
                    *(u32x4*)(rowp + bj * HALF) = w; } }
    }
};
template <int MODE> struct EpiGate {
    static constexpr bool PERM = true, AFTER_DRAIN = false;
    const bf16_t* G; bf16_t* O;
    __device__ __forceinline__ void operator()(const f32x4 (&acc)[2][2][4][2], const Unit& u, int wr, int wc, int fr, int fq) const {
        const int row0 = u.pm * BM + wr * 64 + fr, col0 = u.pn * BM + wc * 32 + 8 * fq;
#pragma unroll
        for (int ai = 0; ai < 2; ++ai)
#pragma unroll
            for (int m = 0; m < 4; ++m) { const size_t ro = (size_t)(row0 + ai * HALF + m * 16) * 2048 + col0;
#pragma unroll
                for (int bj = 0; bj < 2; ++bj) { const size_t off = ro + bj * HALF; const u32x4 g = *(const u32x4*)(G + off);
                    f32x4 v0 = acc[ai][bj][m][0], v1 = acc[ai][bj][m][1];
                    v0[0] *= bf_lo(g.x); v0[1] *= bf_hi(g.x); v0[2] *= bf_lo(g.y); v0[3] *= bf_hi(g.y); v1[0] *= bf_lo(g.z); v1[1] *= bf_hi(g.z); v1[2] *= bf_lo(g.w); v1[3] *= bf_hi(g.w);
                    if (MODE == 1) { const u32x4 p = *(const u32x4*)(O + off);
                        v0[0] += bf_lo(p.x); v0[1] += bf_hi(p.x); v0[2] += bf_lo(p.y); v0[3] += bf_hi(p.y); v1[0] += bf_lo(p.z); v1[1] += bf_hi(p.z); v1[2] += bf_lo(p.w); v1[3] += bf_hi(p.w); }
                    u32x4 w; w.x = cvt_pk_bf16(v0[0], v0[1]); w.y = cvt_pk_bf16(v0[2], v0[3]); w.z = cvt_pk_bf16(v1[0], v1[1]); w.w = cvt_pk_bf16(v1[2], v1[3]);
                    *(u32x4*)(O + off) = w; } }
    }
};
template <bool WITH_A5> struct EpiRes {
    static constexpr bool PERM = false, AFTER_DRAIN = false;
    const float* R; float* H; bf16_t* a5; const float* gm; float* rowss;
    __device__ __forceinline__ void operator()(const f32x4 (&acc)[2][2][4][2], const Unit& u, int wr, int wc, int fr, int fq) const {
        const int row0 = u.pm * BM + wr * 64 + fr, col0 = u.pn * BM + wc * 32 + 4 * fq;
#pragma unroll
        for (int ai = 0; ai < 2; ++ai)
#pragma unroll
            for (int m = 0; m < 4; ++m) { const int row = row0 + ai * HALF + m * 16; const size_t ro = (size_t)row * 2048 + col0; float ss = 0.f;
#pragma unroll
                for (int bj = 0; bj < 2; ++bj)
#pragma unroll
                    for (int n = 0; n < 2; ++n) { const size_t off = ro + bj * HALF + n * 16; const f32x4 hv = *(const f32x4*)(R + off) + acc[ai][bj][m][n];
                        *(f32x4*)(H + off) = hv; ss += (hv[0] * hv[0] + hv[1] * hv[1]) + (hv[2] * hv[2] + hv[3] * hv[3]);
                        if (WITH_A5) { const f32x4 gv = *(const f32x4*)(gm + col0 + bj * HALF + n * 16); u32x2 w; w.x = cvt_pk_bf16(hv[0] * gv[0], hv[1] * gv[1]); w.y = cvt_pk_bf16(hv[2] * gv[2], hv[3] * gv[3]); *(u32x2*)(a5 + off) = w; } }
                ss += __shfl_xor(ss, 16); ss += __shfl_xor(ss, 32);
                if (fq == 0) atomicAdd(rowss + row, ss); }
    }
};
struct EpiUp {
    static constexpr bool PERM = true, AFTER_DRAIN = false;
    const float* rowss; bf16_t* O;
    __device__ __forceinline__ void operator()(const f32x4 (&acc)[2][2][4][2], const Unit& u, int wr, int wc, int fr, int fq) const {
        const int row0 = u.pm * BM + wr * 64 + fr, col0 = u.pn * BM + wc * 32 + 8 * fq;
#pragma unroll
        for (int ai = 0; ai < 2; ++ai)
#pragma unroll
            for (int m = 0; m < 4; ++m) { const int row = row0 + ai * HALF + m * 16; const float rs = 1.0f / sqrtf(rowss[row] * (1.0f / 2048.0f) + 1e-6f); bf16_t* rowp = O + (size_t)row * 8192 + col0;
#pragma unroll
                for (int bj = 0; bj < 2; ++bj) { f32x4 v0 = acc[ai][bj][m][0] * rs, v1 = acc[ai][bj][m][1] * rs;
#pragma unroll
                    for (int e = 0; e < 4; ++e) { const float a = fmaxf(v0[e], 0.f), b = fmaxf(v1[e], 0.f); v0[e] = a * a; v1[e] = b * b; }
                    u32x4 w; w.x = cvt_pk_bf16(v0[0], v0[1]); w.y = cvt_pk_bf16(v0[2], v0[3]); w.z = cvt_pk_bf16(v1[0], v1[1]); w.w = cvt_pk_bf16(v1[2], v1[3]);
                    *(u32x4*)(rowp + bj * HALF) = w; } }
    }
};

template <class Epi, class Sched, bool ALIGN_EPI = false, bool SP2 = false>
__device__ __forceinline__ void gemm_phase(PG8_LAS unsigned char* lds, const Gemm g, const Sched& S, const Epi& E) {
    const int tid = threadIdx.x, wid = __builtin_amdgcn_readfirstlane(tid >> 6), lane = tid & 63, wr = wid >> 2, wc = wid & 3, fr = lane & 15, fq = lane >> 4;
    const int K = g.K, nt = K / BK;
    unsigned voffA[2], voffB[2];
#pragma unroll
    for (int i = 0; i < 2; ++i) { int R, C; stage_rc(tid * 16 + i * 8192, R, C); const int Rb = Epi::PERM ? ((R & ~31) + perm32(R & 31)) : R;
        voffA[i] = (unsigned)(R * g.lda + C) * 2u; voffB[i] = (unsigned)(Rb * K + C) * 2u; }
    const long kfull = (long)(nt - 1) * (BK * 2);
    long kstep = (g.kdir != 0) ? -(long)(BK * 2) : (long)(BK * 2), kstepn = kstep;
    const size_t hstepA = (size_t)HALF * g.lda * 2, hstepB = (size_t)HALF * K * 2;
    const size_t tstepA = 2 * hstepA, tstepB = 2 * hstepB;
    const unsigned ldsw = (unsigned)wid * 1024u;
    const int aoff = lds_byte(wr * 64 + fr, fq * 8), boff = lds_byte(wc * 32 + fr, fq * 8);
#define PG8_SA(b, h) (((b) * 2 + (h)) * HTB)
#define PG8_SB(b, h) ((4 + (b) * 2 + (h)) * HTB)
#define PG8_STAGE(bufoff, gbase, voff) do { _Pragma("unroll") for (int _i = 0; _i < 2; ++_i) \
        __builtin_amdgcn_global_load_lds((const unsigned*)((const char*)(gbase) + (voff)[_i]), (PG8_LAS unsigned*)(lds + (bufoff) + ldsw + _i * 8192), 16, 0, 0); } while (0)
#define PG8_LDA(dst, b, h) do { _Pragma("unroll") for (int m = 0; m < 4; ++m) _Pragma("unroll") for (int k = 0; k < 2; ++k) dst[m][k] = *(const PG8_LAS bf16x8*)(lds + PG8_SA(b, h) + aoff + m * 2048 + k * 1024); } while (0)
#define PG8_LDB(dst, b, h) do { _Pragma("unroll") for (int n = 0; n < 2; ++n) _Pragma("unroll") for (int k = 0; k < 2; ++k) dst[n][k] = *(const PG8_LAS bf16x8*)(lds + PG8_SB(b, h) + boff + n * 2048 + k * 1024); } while (0)
#define PG8_MMA(ai, bj, At, Bt) do { __builtin_amdgcn_s_setprio(1); _Pragma("unroll") for (int m = 0; m < 4; ++m) _Pragma("unroll") for (int n = 0; n < 2; ++n) _Pragma("unroll") for (int k = 0; k < 2; ++k) \
        acc[ai][bj][m][n] = __builtin_amdgcn_mfma_f32_16x16x32_bf16(Bt[n][k], At[m][k], acc[ai][bj][m][n], 0, 0, 0); __builtin_amdgcn_s_setprio(0); } while (0)
#define PG8_WAIT_V(n) asm volatile("s_waitcnt vmcnt(" #n ")" ::: "memory")
#define PG8_WAIT_L(n) asm volatile("s_waitcnt lgkmcnt(" #n ")" ::: "memory")
#define PG8_BAR __builtin_amdgcn_s_barrier()
#define PG8_SCHED __builtin_amdgcn_sched_barrier(0)
    Unit cur, nxt; int ui = 0;
    if (!S.next(0, cur)) return;
    f32x4 acc[2][2][4][2];
#pragma unroll
    for (int a = 0; a < 2; ++a)
#pragma unroll
        for (int b = 0; b < 2; ++b)
#pragma unroll
            for (int m = 0; m < 4; ++m)
#pragma unroll
                for (int n = 0; n < 2; ++n) acc[a][b][m][n] = (f32x4){0.f, 0.f, 0.f, 0.f};
    bf16x8 At[4][2], B0[2][2], B1[2][2];
    const char* cA = (const char*)g.A + (size_t)cur.pm * tstepA + (kstep < 0 ? kfull : 0); const char* cB = (const char*)g.Bt + (size_t)cur.pn * tstepB + (kstep < 0 ? kfull : 0);
    S.a_ready(cur);
    if constexpr (SP2) {
        PG8_STAGE(PG8_SB(0, 0), cB, voffB); PG8_STAGE(PG8_SB(0, 1), cB + hstepB, voffB); PG8_STAGE(PG8_SA(0, 0), cA, voffA); PG8_STAGE(PG8_SA(0, 1), cA + hstepA, voffA);
        if (wr == 1) PG8_BAR;
        PG8_WAIT_V(2); PG8_BAR;
        PG8_STAGE(PG8_SB(1, 0), cB + kstep, voffB); PG8_STAGE(PG8_SA(1, 0), cA + kstep, voffA); PG8_STAGE(PG8_SB(1, 1), cB + hstepB + kstep, voffB);
        PG8_WAIT_V(6); PG8_BAR;
    } else {
        PG8_STAGE(PG8_SB(0, 0), cB, voffB); PG8_STAGE(PG8_SA(0, 0), cA, voffA); PG8_STAGE(PG8_SB(0, 1), cB + hstepB, voffB); PG8_STAGE(PG8_SA(0, 1), cA + hstepA, voffA);
        if (wr == 1) PG8_BAR;
        PG8_WAIT_V(4); PG8_BAR;
        PG8_STAGE(PG8_SB(1, 0), cB + kstep, voffB); PG8_STAGE(PG8_SA(1, 0), cA + kstep, voffA); PG8_STAGE(PG8_SB(1, 1), cB + hstepB + kstep, voffB);
        PG8_WAIT_V(6); PG8_BAR;
    }
    for (;;) {
        const bool has_next = S.next(ui + 1, nxt);
        kstepn = (has_next && g.kdir != 0) ? -kstep : kstep;
        const char* nA = has_next ? (const char*)g.A + (size_t)nxt.pm * tstepA + (kstepn < 0 ? kfull : 0) : cA; const char* nB = has_next ? (const char*)g.Bt + (size_t)nxt.pn * tstepB + (kstepn < 0 ? kfull : 0) : cB;
        for (int t = 0; t < nt; t += 2) {
            const bool last = (t == nt - 2);
            const char* a1 = cA + (long)(t + 1) * kstep;
            const char* a2 = last ? nA : cA + (long)(t + 2) * kstep; const char* b2 = last ? nB : cB + (long)(t + 2) * kstep;
            const char* a3 = a2 + (last ? kstepn : kstep); const char* b3 = b2 + (last ? kstepn : kstep);
            if (last && has_next) S.a_ready(nxt);
            if constexpr (SP2) {
            PG8_LDB(B0, 0, 0); PG8_LDB(B1, 0, 1); PG8_SCHED; PG8_LDA(At, 0, 0); PG8_STAGE(PG8_SA(1, 1), a1 + hstepA, voffA);
            PG8_WAIT_V(8); PG8_WAIT_L(0); PG8_BAR; PG8_MMA(0, 0, At, B0); PG8_MMA(0, 1, At, B1); PG8_BAR; PG8_SCHED;
            PG8_LDA(At, 0, 1); PG8_STAGE(PG8_SB(0, 0), b2, voffB); PG8_STAGE(PG8_SB(0, 1), b2 + hstepB, voffB); PG8_STAGE(PG8_SA(0, 0), a2, voffA);
            PG8_WAIT_V(8); PG8_WAIT_L(0); PG8_BAR; PG8_MMA(1, 0, At, B0); PG8_MMA(1, 1, At, B1); PG8_BAR; PG8_SCHED;
            PG8_LDB(B0, 1, 0); PG8_LDB(B1, 1, 1); PG8_SCHED; PG8_LDA(At, 1, 0); PG8_STAGE(PG8_SA(0, 1), a2 + hstepA, voffA);
            PG8_WAIT_V(8); PG8_WAIT_L(0); PG8_BAR; PG8_MMA(0, 0, At, B0); PG8_MMA(0, 1, At, B1); PG8_BAR; PG8_SCHED;
            PG8_LDA(At, 1, 1); PG8_STAGE(PG8_SB(1, 0), b3, voffB); PG8_STAGE(PG8_SB(1, 1), b3 + hstepB, voffB); PG8_STAGE(PG8_SA(1, 0), a3, voffA);
            PG8_WAIT_V(8); PG8_WAIT_L(0); PG8_BAR; PG8_MMA(1, 0, At, B0); PG8_MMA(1, 1, At, B1); PG8_BAR; PG8_SCHED;
            } else {
            PG8_LDB(B0, 0, 0); PG8_SCHED; PG8_LDA(At, 0, 0); PG8_STAGE(PG8_SA(1, 1), a1 + hstepA, voffA);
            PG8_WAIT_L(8); PG8_BAR; PG8_WAIT_L(0); PG8_MMA(0, 0, At, B0); PG8_BAR; PG8_SCHED;
            PG8_LDB(B1, 0, 1); PG8_STAGE(PG8_SB(0, 0), b2, voffB);
            PG8_BAR; PG8_WAIT_L(0); PG8_MMA(0, 1, At, B1); PG8_BAR;
            PG8_LDA(At, 0, 1); PG8_STAGE(PG8_SA(0, 0), a2, voffA);
            PG8_BAR; PG8_WAIT_L(0); PG8_MMA(1, 0, At, B0); PG8_BAR; PG8_SCHED;
            PG8_STAGE(PG8_SB(0, 1), b2 + hstepB, voffB);
            PG8_WAIT_V(6); PG8_BAR; PG8_MMA(1, 1, At, B1); PG8_BAR;
            PG8_LDB(B0, 1, 0); PG8_SCHED; PG8_LDA(At, 1, 0); PG8_STAGE(PG8_SA(0, 1), a2 + hstepA, voffA);
            PG8_WAIT_L(8); PG8_BAR; PG8_WAIT_L(0); PG8_MMA(0, 0, At, B0); PG8_BAR; PG8_SCHED;
            PG8_LDB(B1, 1, 1); PG8_STAGE(PG8_SB(1, 0), b3, voffB);
            PG8_BAR; PG8_WAIT_L(0); PG8_MMA(0, 1, At, B1); PG8_BAR;
            PG8_LDA(At, 1, 1); PG8_STAGE(PG8_SA(1, 0), a3, voffA);
            PG8_BAR; PG8_WAIT_L(0); PG8_MMA(1, 0, At, B0); PG8_BAR; PG8_SCHED;
            PG8_STAGE(PG8_SB(1, 1), b3 + hstepB, voffB);
            PG8_WAIT_V(6); PG8_BAR; PG8_MMA(1, 1, At, B1); PG8_BAR;
            }
        }
        if constexpr (ALIGN_EPI) { if (wr == 0) PG8_BAR; }
        if constexpr (!Epi::AFTER_DRAIN) { E(acc, cur, wr, wc, fr, fq); S.done(cur); }
        if (!has_next) break;
#pragma unroll
        for (int a = 0; a < 2; ++a)
#pragma unroll
            for (int b = 0; b < 2; ++b)
#pragma unroll
                for (int m = 0; m < 4; ++m)
#pragma unroll
                    for (int n = 0; n < 2; ++n) acc[a][b][m][n] = (f32x4){0.f, 0.f, 0.f, 0.f};
        cur = nxt; cA = nA; cB = nB; kstep = kstepn; ++ui;
        if constexpr (ALIGN_EPI) { if (wr == 1) PG8_BAR; }
    }
    PG8_WAIT_V(0);
    if constexpr (!ALIGN_EPI) { if (wr == 0) PG8_BAR; }
    PG8_BAR;
    if constexpr (Epi::AFTER_DRAIN) { E.fused(acc, cur, wr, wc, fr, fq, lds, wid, lane); S.done(cur); }
#undef PG8_SA
#undef PG8_SB
#undef PG8_STAGE
#undef PG8_LDA
#undef PG8_LDB
#undef PG8_MMA
#undef PG8_WAIT_V
#undef PG8_WAIT_L
#undef PG8_BAR
#undef PG8_SCHED
}
}
#ifndef ONE_LAUNCH
#define ONE_LAUNCH 1
#endif
#ifndef USE_NAIVE_ATTN
#define USE_NAIVE_ATTN 0
#endif
#ifndef USE_NAIVE_LRU
#define USE_NAIVE_LRU 0
#endif
#ifndef PG8_SP2
#define PG8_SP2 true
#endif
#ifndef PG8_ALIGN
#define PG8_ALIGN true
#endif
constexpr int NWAVES = 8;
constexpr int BATCH = 8, SEQ = 2048, D = 2048, NH = 16, HD = 128, FF = 8192, INC = 14336;
constexpr int M = BATCH * SEQ;
constexpr float EPS = 1e-6f;
constexpr float LOG2E = 1.4426950408889634f;
constexpr float QSCALE = 0.08838834764831845f * LOG2E;
constexpr size_t MiB = 1u << 20;
constexpr size_t WS_CTL = 0, WS_RSS1 = 1 * MiB, WS_RSS2 = 1 * MiB + 65536, WS_LSE2 = 2 * MiB, WS_LSE3 = 3 * MiB;
constexpr size_t WS_WPA = 8 * MiB, WS_WPL = 16 * MiB, WS_WOUT = 24 * MiB;
constexpr size_t WS_WIN = 32 * MiB;
constexpr size_t WS_O3 = 32 * MiB, WS_A5 = 32 * MiB;
constexpr size_t WS_Q = 96 * MiB, WS_K = 160 * MiB, WS_V = 224 * MiB, WS_XR = 288 * MiB, WS_GA = 352 * MiB, WS_GL = 416 * MiB;
constexpr size_t WS_WUP = 480 * MiB;
constexpr size_t WS_MRG = 96 * MiB;
constexpr size_t WS_WDN = 160 * MiB;
constexpr size_t WS_HID = 224 * MiB;
constexpr size_t WS_END = 512 * MiB;
constexpr int RING_BYTES = 131072, MISC_OFF = RING_BYTES, LDS_BYTES = 147456;
constexpr size_t CTL_ZERO_BYTES = 65536; constexpr int CW_BAR = 4096;

#define GAS __attribute__((address_space(1)))
#define LAS __attribute__((address_space(3)))
typedef unsigned short bf16;
typedef unsigned v4u __attribute__((ext_vector_type(4)));
typedef unsigned v2u __attribute__((ext_vector_type(2)));
typedef float f32x4 __attribute__((ext_vector_type(4)));
typedef short bf16x8 __attribute__((ext_vector_type(8)));
#define LDS_WAIT() asm volatile("s_waitcnt lgkmcnt(0)" ::: "memory")
#define VM_WAIT() asm volatile("s_waitcnt vmcnt(0)" ::: "memory")
__device__ __forceinline__ unsigned f2bf(float f) { unsigned u = __builtin_bit_cast(unsigned, f); return (u + 0x7fffu + ((u >> 16) & 1u)) >> 16; }
__device__ __forceinline__ unsigned pk2(float lo, float hi) { return f2bf(lo) | (f2bf(hi) << 16); }
__device__ __forceinline__ float bf2f(unsigned short b) { return __uint_as_float((unsigned)b << 16); }
__device__ __forceinline__ float wave_sum(float v) {
#pragma unroll
    for (int o = 1; o < 64; o <<= 1) v += __shfl_xor(v, o);
    return v;
}
__device__ __forceinline__ float gelu_tanh(float x) { const float z = 0.7978845608028654f * (x + 0.044715f * x * x * x); const float e = __expf(2.0f * z); const float th = 1.0f - 2.0f / (1.0f + e); return 0.5f * x * (1.0f + th); }

#define RLX_AGENT __ATOMIC_RELAXED, __HIP_MEMORY_SCOPE_AGENT
#define XB_TMO      128
#define XB_XCNT(j)  (256  + 64 * (j))
#define XB_XSUB(j)  (1280 + 64 * (j))
#define XB_XGEN(j)  (2304 + 64 * (j))
#define XB_TOP      3328
#define XB_TOPGEN   3392
#define XCD_BAR_WORDS 3456
#define XB_SPIN_CAP (1u << 18)

__device__ __forceinline__ unsigned xb_ld(unsigned* p)              { return __hip_atomic_load(p, __ATOMIC_RELAXED, __HIP_MEMORY_SCOPE_AGENT); }
__device__ __forceinline__ unsigned xb_add(unsigned* p, unsigned v) { return __hip_atomic_fetch_add(p, v, __ATOMIC_RELAXED, __HIP_MEMORY_SCOPE_AGENT); }
__device__ __forceinline__ unsigned xb_xcc_id() { return (unsigned)__builtin_amdgcn_s_getreg((3 << 11) | 20) & 0xFu; }
#define XB_SPIN(cond, bar) do { unsigned _sp = 0; while (cond) { __builtin_amdgcn_s_sleep(1); \
    if ((++_sp & 255u) == 0u) { if (xb_ld(&(bar)[XB_TMO])) break; if (_sp > XB_SPIN_CAP) { atomicAdd(&(bar)[XB_TMO], 1u); break; } } } } while (0)

struct XcdBarrier {
    unsigned* bar; unsigned x;
    volatile LAS unsigned* st;
};

__device__ __forceinline__ XcdBarrier xcd_barrier_post(unsigned* bar, volatile LAS unsigned* st) {
    XcdBarrier b; b.bar = bar; b.x = xb_xcc_id(); b.st = st;
    if (threadIdx.x == 0) { const unsigned old_ = xb_add(&bar[XB_XCNT(b.x)], 1u); st[2] = old_; st[3] = b.x; }
    return b;
}
__device__ __forceinline__ void xcd_barrier_complete(unsigned* bar, unsigned x, unsigned& nloc, unsigned& nx) {
    const unsigned G = gridDim.x * gridDim.y * gridDim.z;
    unsigned sum, cnt, mine, sp = 0u;
    for (;;) {
        sum = 0u; cnt = 0u; mine = 0u;
#pragma unroll
        for (unsigned j = 0; j < 16; ++j) { const unsigned c = xb_ld(&bar[XB_XCNT(j)]); sum += c; cnt += (c > 0u) ? 1u : 0u; mine = (j == x) ? c : mine; }
        if (sum == G) break;
        __builtin_amdgcn_s_sleep(1);
        if ((++sp & 255u) == 0u) { if (xb_ld(&bar[XB_TMO])) break; if (sp > XB_SPIN_CAP) { atomicAdd(&bar[XB_TMO], 1u); break; } }
    }
    nloc = mine > 0u ? mine : 1u; nx = cnt > 0u ? cnt : 1u;
}

__device__ __forceinline__ void xcd_barrier(const XcdBarrier& b) {
    asm volatile("s_waitcnt vmcnt(0)" ::: "memory");
    __syncthreads();
    if (threadIdx.x == 0) {
        unsigned* bar = b.bar;
        __builtin_amdgcn_s_waitcnt(0);
        unsigned nloc = b.st[0], nx = b.st[1];
        if (nloc == 0u) { xcd_barrier_complete(bar, b.x, nloc, nx); b.st[0] = nloc; b.st[1] = nx; }
        const unsigned old = xb_add(&bar[XB_XSUB(b.x)], 1u);
        const unsigned gen = old / nloc;
        if (old + 1u == (gen + 1u) * nloc) {
            __builtin_amdgcn_fence(__ATOMIC_RELEASE, "agent");
            asm volatile("s_waitcnt vmcnt(0)" ::: "memory");
            const unsigned og = xb_add(&bar[XB_TOP], 1u);
            const unsigned tg = og / nx;
            if (og + 1u == (tg + 1u) * nx) xb_add(&bar[XB_TOPGEN], 1u);
            else XB_SPIN(xb_ld(&bar[XB_TOPGEN]) == tg, bar);
            __builtin_amdgcn_fence(__ATOMIC_ACQUIRE, "agent");
            xb_add(&bar[XB_XGEN(b.x)], 1u);
            asm volatile("s_waitcnt vmcnt(0)" ::: "memory");
        } else {
            XB_SPIN(xb_ld(&bar[XB_XGEN(b.x)]) == gen, bar);
            __builtin_amdgcn_fence(__ATOMIC_ACQUIRE, "agent");
            asm volatile("s_waitcnt vmcnt(0)" ::: "memory");
        }
    }
    __syncthreads();
}

struct Frame { LAS unsigned char* lds; int tid, lane, wave, vcu, G; };

__device__ __forceinline__ void p0_transpose_item(const float* W, int K, int N, bf16* WT, LAS float* scr, int item, int lane) {
    const int nblk = N / 32, kb = item / nblk, nb = item % nblk, k0 = 64 * kb, n0 = 32 * nb;
#pragma unroll 8
    for (int i = 0; i < 32; ++i) { const int kk = 2 * i + (lane >> 5); scr[kk * 33 + (lane & 31)] = __builtin_nontemporal_load(W + (size_t)(k0 + kk) * N + n0 + (lane & 31)); }
    LDS_WAIT(); asm volatile("" ::: "memory");
    const int c = lane & 7;
#pragma unroll
    for (int j = 0; j < 4; ++j) { const int n = (lane >> 3) + 8 * j; const LAS float* s = scr + (8 * c) * 33 + n;
        v4u o; o.x = pk2(s[0 * 33], s[1 * 33]); o.y = pk2(s[2 * 33], s[3 * 33]); o.z = pk2(s[4 * 33], s[5 * 33]); o.w = pk2(s[6 * 33], s[7 * 33]);
        *(GAS v4u*)(WT + (size_t)(n0 + n) * K + k0 + 8 * c) = o; }
    LDS_WAIT(); asm volatile("" ::: "memory");
}
__device__ __forceinline__ void transpose_all(const Frame& F, const float* W, int K, int N, bf16* WT) {
    LAS float* scr = (LAS float*)(F.lds + F.wave * 16384);
    const int gw = F.vcu * NWAVES + F.wave, NGW = F.G * NWAVES, nitems = (K / 64) * (N / 32);
    for (int it = gw; it < nitems; it += NGW) p0_transpose_item(W, K, N, WT, scr, it, F.lane);
}
__device__ __forceinline__ void rms_row_to_bf16(const Frame& F, const float* xrow, const float* g, bf16* orow) {
    const GAS f32x4* xr = (const GAS f32x4*)xrow + F.lane; const GAS f32x4* gr = (const GAS f32x4*)g + F.lane;
    f32x4 v[8]; float s = 0.f;
#pragma unroll
    for (int j = 0; j < 8; ++j) { v[j] = __builtin_nontemporal_load(xr + 64 * j); s += (v[j].x * v[j].x + v[j].y * v[j].y) + (v[j].z * v[j].z + v[j].w * v[j].w); }
    const float rstd = 1.f / sqrtf(wave_sum(s) * (1.f / D) + EPS);
    GAS v2u* o8 = (GAS v2u*)orow + F.lane;
#pragma unroll
    for (int j = 0; j < 8; ++j) { const f32x4 gg = gr[64 * j]; v2u w; w.x = pk2(v[j].x * rstd * gg.x, v[j].y * rstd * gg.y); w.y = pk2(v[j].z * rstd * gg.z, v[j].w * rstd * gg.w); o8[64 * j] = w; }
}

typedef short s16x4 __attribute__((ext_vector_type(4)));
__device__ __forceinline__ s16x4 tr_read16(LAS unsigned char* p) { return __builtin_amdgcn_ds_read_tr16_b64_v4i16((LAS s16x4*)p); }
#define WG_BAR() do { asm volatile("s_waitcnt lgkmcnt(0)" ::: "memory"); __builtin_amdgcn_s_barrier(); asm volatile("" ::: "memory"); } while (0)
struct AUnit { int b, h, d, r, n; bf16* Og; int ldo; float* Lg; };
struct DecP2 { bf16* o2; bf16* o3; float* l2; float* l3;
    __device__ __forceinline__ void operator()(int u, AUnit& a) const { const int bh = u >> 5, sub = u & 31; a.b = bh >> 4; a.h = bh & 15;
        if (sub < 16) { a.d = 4; a.r = sub & 3; a.n = sub >> 2; a.Og = o2; a.ldo = 4096; a.Lg = l2; } else { a.d = 16; a.r = sub - 16; a.n = 0; a.Og = o3; a.ldo = 2048; a.Lg = l3; } } };
struct DecP3 { bf16* y;
    __device__ __forceinline__ void operator()(int u, AUnit& a) const { const int bh = u >> 4; a.b = bh >> 4; a.h = bh & 15; a.d = 1; a.r = 0; a.n = u & 15; a.Og = y; a.ldo = 4096; a.Lg = nullptr; } };
template <bool VSW>
__device__ __forceinline__ void attn_issue(const Frame& F, const bf16* X, const AUnit& a, int ldsoff) {
    const int lane = F.lane, w = F.wave, g = lane >> 4, ql = lane & 15;
#pragma unroll
    for (int i = 0; i < 8; ++i) { const int rg = w + 8 * i, j = 4 * rg + g, jr = j & 15, c = ql ^ (VSW ? (((jr & 7) << 1) | (jr >> 3)) : jr);
        if (i >= 4 || a.n > 0) {
            const size_t go = ((size_t)(a.b * SEQ + ((a.n - 1) * 128 + j) * a.d + a.r) * 2048 + a.h * 128 + c * 8) * 2;
            __builtin_amdgcn_global_load_lds((const unsigned*)((const char*)X + go), (LAS unsigned*)(F.lds + ldsoff + rg * 1024), 16, 0, 0); } }
}
__device__ __forceinline__ void tr_read10(unsigned addr, s16x4 (&f)[10]) {
    asm volatile("ds_read_b64_tr_b16 %0, %10\n\tds_read_b64_tr_b16 %1, %10 offset:4096\n\tds_read_b64_tr_b16 %2, %10 offset:8192\n\tds_read_b64_tr_b16 %3, %10 offset:12288\n\t"
                 "ds_read_b64_tr_b16 %4, %10 offset:16384\n\tds_read_b64_tr_b16 %5, %10 offset:20480\n\tds_read_b64_tr_b16 %6, %10 offset:24576\n\tds_read_b64_tr_b16 %7, %10 offset:28672\n\t"
                 "ds_read_b64_tr_b16 %8, %10 offset:32768\n\tds_read_b64_tr_b16 %9, %10 offset:32768\n\ts_waitcnt lgkmcnt(0)"
                 : "=&v"(f[0]), "=&v"(f[1]), "=&v"(f[2]), "=&v"(f[3]), "=&v"(f[4]), "=&v"(f[5]), "=&v"(f[6]), "=&v"(f[7]), "=&v"(f[8]), "=&v"(f[9]) : "v"(addr) : "memory");
}
__device__ __forceinline__ void tr_issue10(unsigned addr, s16x4 (&f)[10]) {
    asm volatile("ds_read_b64_tr_b16 %0, %10\n\tds_read_b64_tr_b16 %1, %10 offset:4096\n\tds_read_b64_tr_b16 %2, %10 offset:8192\n\tds_read_b64_tr_b16 %3, %10 offset:12288\n\t"
                 "ds_read_b64_tr_b16 %4, %10 offset:16384\n\tds_read_b64_tr_b16 %5, %10 offset:20480\n\tds_read_b64_tr_b16 %6, %10 offset:24576\n\tds_read_b64_tr_b16 %7, %10 offset:28672\n\t"
                 "ds_read_b64_tr_b16 %8, %10 offset:32768\n\tds_read_b64_tr_b16 %9, %10 offset:32768"
                 : "=&v"(f[0]), "=&v"(f[1]), "=&v"(f[2]), "=&v"(f[3]), "=&v"(f[4]), "=&v"(f[5]), "=&v"(f[6]), "=&v"(f[7]), "=&v"(f[8]), "=&v"(f[9]) : "v"(addr) : "memory");
}
template <int N> __device__ __forceinline__ void tr_wait10(s16x4 (&f)[10]) {
    if (N == 10) asm volatile("s_waitcnt lgkmcnt(10)" : "+v"(f[0]), "+v"(f[1]), "+v"(f[2]), "+v"(f[3]), "+v"(f[4]), "+v"(f[5]), "+v"(f[6]), "+v"(f[7]), "+v"(f[8]), "+v"(f[9]) :: "memory");
    else         asm volatile("s_waitcnt lgkmcnt(0)"  : "+v"(f[0]), "+v"(f[1]), "+v"(f[2]), "+v"(f[3]), "+v"(f[4]), "+v"(f[5]), "+v"(f[6]), "+v"(f[7]), "+v"(f[8]), "+v"(f[9]) :: "memory");
}
__device__ __forceinline__ void q_load4(const bf16* p, bf16x8 (&q)[4]) {
    asm volatile("global_load_dwordx4 %0, %4, off\n\tglobal_load_dwordx4 %1, %4, off offset:64\n\tglobal_load_dwordx4 %2, %4, off offset:128\n\tglobal_load_dwordx4 %3, %4, off offset:192"
                 : "=&v"(q[0]), "=&v"(q[1]), "=&v"(q[2]), "=&v"(q[3]) : "v"(p) : "memory");
}
template <int MODE, class Dec>
__device__ __forceinline__ void attn_phase(const Frame& F, const bf16* Q, const bf16* K, const bf16* V, int nunits, const Dec dec, const bf16* O3, const float* L2, const float* L3) {
    const int lane = F.lane, w = F.wave, g = lane >> 4, ql = lane & 15;
    LAS unsigned char* lds = F.lds;
    int u = F.vcu; if (u >= nunits) return;
    AUnit cur, nxt; dec(u, cur); nxt = cur;
    __syncthreads();
    for (int i = F.tid; i < 2048; i += NWAVES * 64) { *(LAS v4u*)(lds + i * 16) = (v4u){0u, 0u, 0u, 0u}; *(LAS v4u*)(lds + 65536 + i * 16) = (v4u){0u, 0u, 0u, 0u}; }
    __syncthreads();
    attn_issue<false>(F, K, cur, 0); attn_issue<true>(F, V, cur, 65536);
    bf16x8 qf[4], qn[4];
    q_load4(Q + (size_t)(cur.b * SEQ + (cur.n * 128 + 16 * w + ql) * cur.d + cur.r) * 2048 + cur.h * 128 + 8 * g, qf);
    asm volatile("s_waitcnt vmcnt(0)" ::: "memory");
#pragma unroll
    for (int ks = 0; ks < 4; ++ks) qn[ks] = qf[ks];
    const LAS unsigned char* kb = lds + (16 * w + ql) * 256;
    unsigned ksw[4];
#pragma unroll
    for (int ks = 0; ks < 4; ++ks) ksw[ks] = (unsigned)(((4 * ks + g) ^ ql) << 4);
    const int q4 = (lane >> 2) & 3, p4 = lane & 3, rl = 4 * g + q4;
    const int frl = ((rl & 7) << 1) | (rl >> 3);
    LAS unsigned char* vb = lds + 65536 + (16 * w + rl) * 256 + 8 * (p4 & 1);
    const float NEG = -INFINITY;
    for (;;) {
        const int un = u + F.G; const bool has_next = un < nunits; if (has_next) dec(un, nxt);
        const int n = cur.n, h = cur.h, d = cur.d;
        const int qi = 16 * w + ql;
        const size_t qrow = (size_t)(cur.b * SEQ + (n * 128 + qi) * d + cur.r);
        WG_BAR();
        const float sl = exp2f(-0.5f * (float)(h + 1)) * LOG2E * (float)d, cb = -sl * (float)(128 + ql - 4 * g);
        f32x4 s[9];
        __builtin_amdgcn_s_setprio(1);
#pragma unroll
        for (int tt = 0; tt < 9; ++tt) {
            s[tt] = (f32x4){fmaf(sl, (float)(16 * tt), cb), fmaf(sl, (float)(16 * tt + 1), cb), fmaf(sl, (float)(16 * tt + 2), cb), fmaf(sl, (float)(16 * tt + 3), cb)};
#pragma unroll
            for (int ks = 0; ks < 4; ++ks) { const bf16x8 a = *(const LAS bf16x8*)(kb + ksw[ks] + tt * 4096); s[tt] = __builtin_amdgcn_mfma_f32_16x16x32_bf16(a, qf[ks], s[tt], 0, 0, 0); }
        }
        __builtin_amdgcn_s_setprio(0);
        WG_BAR();
        v2u a2[8], a3[8]; float l2v = 0.f, l3v = 0.f;
        bf16* op = cur.Og + qrow * (size_t)cur.ldo + h * 128 + 4 * g;
        if (MODE == 1) { const bf16* o3p = O3 + qrow * 2048 + h * 128 + 4 * g;
#pragma unroll
            for (int dt = 0; dt < 8; ++dt) { a2[dt] = *(const v2u*)(op + 16 * dt); a3[dt] = *(const v2u*)(o3p + 16 * dt); }
            l2v = L2[qrow * 16 + h]; l3v = L3[qrow * 16 + h]; }
        if (has_next) { attn_issue<false>(F, K, nxt, 0);
            q_load4(Q + (size_t)(nxt.b * SEQ + (nxt.n * 128 + qi) * nxt.d + nxt.r) * 2048 + nxt.h * 128 + 8 * g, qn); }
#pragma unroll
        for (int e = 0; e < 4; ++e) { if (4 * g + e < ql) s[0][e] = NEG; if (4 * g + e > ql) s[8][e] = NEG; }
        if (n == 0) {
#pragma unroll
            for (int tt = 0; tt < 8; ++tt) { const bool dead = (w + tt < 8);
#pragma unroll
                for (int e = 0; e < 4; ++e) s[tt][e] = dead ? NEG : s[tt][e]; } }
        float mx = NEG;
#pragma unroll
        for (int tt = 0; tt < 9; ++tt) mx = fmaxf(fmaxf(mx, fmaxf(s[tt][0], s[tt][1])), fmaxf(s[tt][2], s[tt][3]));
        mx = fmaxf(mx, __shfl_xor(mx, 16)); mx = fmaxf(mx, __shfl_xor(mx, 32));
        float l = 0.f;
#pragma unroll
        for (int tt = 0; tt < 9; ++tt)
#pragma unroll
            for (int e = 0; e < 4; ++e) { const float p = __builtin_amdgcn_exp2f(s[tt][e] - mx); s[tt][e] = p; l += p; }
        l += __shfl_xor(l, 16); l += __shfl_xor(l, 32);
        bf16x8 pf[5];
#pragma unroll
        for (int pp = 0; pp < 5; ++pp) { const f32x4 px = s[2 * pp], py = (pp < 4) ? s[2 * pp + 1] : (f32x4){0.f, 0.f, 0.f, 0.f};
            v4u u4; u4.x = pg8::cvt_pk_bf16(px[0], px[1]); u4.y = pg8::cvt_pk_bf16(px[2], px[3]); u4.z = pg8::cvt_pk_bf16(py[0], py[1]); u4.w = pg8::cvt_pk_bf16(py[2], py[3]);
            pf[pp] = __builtin_bit_cast(bf16x8, u4); }
        if (has_next) { if (nxt.n > 0) asm volatile("s_waitcnt vmcnt(12)" ::: "memory"); else asm volatile("s_waitcnt vmcnt(8)" ::: "memory"); }
        else asm volatile("s_waitcnt vmcnt(0)" ::: "memory");
        WG_BAR();
        f32x4 o[8];
        s16x4 vfa[10], vfb[10];
        tr_issue10((unsigned)(size_t)(vb + (((p4 >> 1)) ^ frl) * 16), vfa);
#pragma unroll
        for (int dt = 0; dt < 8; dt += 2) {
            tr_issue10((unsigned)(size_t)(vb + (((2 * (dt + 1) + (p4 >> 1)) ^ frl) << 4)), vfb);
            tr_wait10<10>(vfa);
            __builtin_amdgcn_s_setprio(1);
            o[dt] = (f32x4){0.f, 0.f, 0.f, 0.f};
#pragma unroll
            for (int pp = 0; pp < 5; ++pp) { const bf16x8 a = __builtin_shufflevector(vfa[2 * pp], vfa[2 * pp + 1], 0, 1, 2, 3, 4, 5, 6, 7);
                o[dt] = __builtin_amdgcn_mfma_f32_16x16x32_bf16(a, pf[pp], o[dt], 0, 0, 0); }
            __builtin_amdgcn_s_setprio(0);
            if (dt + 2 < 8) { tr_issue10((unsigned)(size_t)(vb + (((2 * (dt + 2) + (p4 >> 1)) ^ frl) << 4)), vfa); tr_wait10<10>(vfb); } else tr_wait10<0>(vfb);
            __builtin_amdgcn_s_setprio(1);
            o[dt + 1] = (f32x4){0.f, 0.f, 0.f, 0.f};
#pragma unroll
            for (int pp = 0; pp < 5; ++pp) { const bf16x8 a = __builtin_shufflevector(vfb[2 * pp], vfb[2 * pp + 1], 0, 1, 2, 3, 4, 5, 6, 7);
                o[dt + 1] = __builtin_amdgcn_mfma_f32_16x16x32_bf16(a, pf[pp], o[dt + 1], 0, 0, 0); }
            __builtin_amdgcn_s_setprio(0);
        }
        WG_BAR();
        asm volatile("s_waitcnt vmcnt(0)" ::: "memory");
        const float linv = 1.0f / l, lse = mx + __builtin_amdgcn_logf(l);
        if (MODE == 0) {
#pragma unroll
            for (int dt = 0; dt < 8; ++dt) { v2u wv; wv.x = pg8::cvt_pk_bf16(o[dt][0] * linv, o[dt][1] * linv); wv.y = pg8::cvt_pk_bf16(o[dt][2] * linv, o[dt][3] * linv); *(v2u*)(op + 16 * dt) = wv; }
            if (g == 0) cur.Lg[qrow * 16 + h] = lse;
        } else {
            const float mm = fmaxf(lse, fmaxf(l2v, l3v));
            float w1 = __builtin_amdgcn_exp2f(lse - mm), w2 = __builtin_amdgcn_exp2f(l2v - mm), w3 = __builtin_amdgcn_exp2f(l3v - mm); const float wi = 1.0f / (w1 + w2 + w3);
            w1 *= wi * linv; w2 *= wi; w3 *= wi;
#pragma unroll
            for (int dt = 0; dt < 8; ++dt) {
                const float y0 = w1 * o[dt][0] + w2 * pg8::bf_lo(a2[dt].x) + w3 * pg8::bf_lo(a3[dt].x), y1 = w1 * o[dt][1] + w2 * pg8::bf_hi(a2[dt].x) + w3 * pg8::bf_hi(a3[dt].x);
                const float y2 = w1 * o[dt][2] + w2 * pg8::bf_lo(a2[dt].y) + w3 * pg8::bf_lo(a3[dt].y), y3 = w1 * o[dt][3] + w2 * pg8::bf_hi(a2[dt].y) + w3 * pg8::bf_hi(a3[dt].y);
                v2u wv; wv.x = pg8::cvt_pk_bf16(y0, y1); wv.y = pg8::cvt_pk_bf16(y2, y3); *(v2u*)(op + 16 * dt) = wv; }
        }
        if (!has_next) break;
        attn_issue<true>(F, V, nxt, 65536);
        cur = nxt; u = un;
#pragma unroll
        for (int ks = 0; ks < 4; ++ks) qf[ks] = qn[ks];
    }
    asm volatile("s_waitcnt vmcnt(0)" ::: "memory");
    __syncthreads();
}

template <int N> __device__ __forceinline__ float row_bcast(float v) {
    return __builtin_bit_cast(float, __builtin_amdgcn_update_dpp(0, __builtin_bit_cast(int, v), 0x150 + N, 0xF, 0xF, false)); }
template <int N> __device__ __forceinline__ float row_shr(float oldv, float v) {
    return __builtin_bit_cast(float, __builtin_amdgcn_update_dpp(__builtin_bit_cast(int, oldv), __builtin_bit_cast(int, v), 0x110 + N, 0xF, 0xF, false)); }
__device__ __forceinline__ float gelu_fast(float x) { const float z = x * (1.0f + 0.044715f * x * x); return x * __builtin_amdgcn_rcpf(1.0f + __builtin_amdgcn_exp2f(-2.0f * 0.7978845608028654f * LOG2E * z)); }

constexpr int LRU_CTAB = 2560, LRU_TOT = 4096, LRU_WFL = 12288, LRU_XBUF = 45056, LRU_XBUF_STRIDE = 36864;
__device__ __forceinline__ void lru_issue_x(const Frame& F, const bf16* XR, int b, int hh, int chunk) {
    const int lane = F.lane, w = F.wave, g = lane >> 4, ql = lane & 15;
#pragma unroll
    for (int i = 0; i < 5; ++i) { const int rg = w + 8 * i;
        if (rg < 33) { const int r = 4 * rg + g; int tok = chunk * 128 - 3 + r; tok = tok < 0 ? 0 : (tok > SEQ - 1 ? SEQ - 1 : tok);
            const size_t go = ((size_t)(b * SEQ + tok) * 2048 + hh * 128 + ((ql ^ (r & 15)) << 3)) * 2;
            __builtin_amdgcn_global_load_lds((const unsigned*)((const char*)XR + go), (LAS unsigned*)(F.lds + LRU_XBUF + (chunk & 1) * LRU_XBUF_STRIDE + rg * 1024), 16, 0, 0); } }
}
__device__ __forceinline__ void lru_item(const Frame& F, const bf16* XR, bf16* XGYL, const float* conv_w, const float* conv_b, const float* wa, const float* ba, const float* wx, const float* bx, const float* lam, int b, int hh, int j2) {
    const int lane = F.lane, w = F.wave, g = lane >> 4, tl = lane & 15;
    LAS float* tab = (LAS float*)F.lds;
    LAS float* ctab = (LAS float*)(F.lds + LRU_CTAB);
    LAS float* tot = (LAS float*)(F.lds + LRU_TOT);
    LAS unsigned char* wfl = F.lds + LRU_WFL;
    __syncthreads();
    for (int i = F.tid; i < 640; i += NWAVES * 64) { const int k = i >> 7, c = i & 127; tab[i] = (k < 4) ? conv_w[k * 2048 + hh * 128 + c] : conv_b[hh * 128 + c]; }
    if (F.tid < 192) { const int k = F.tid >> 6, c = F.tid & 63, ch = hh * 128 + 64 * j2 + c; ctab[F.tid] = (k == 0) ? ba[ch] : (k == 1 ? bx[ch] : 8.0f * log1pf(__expf(-lam[ch]))); }
#pragma unroll
    for (int ff = 0; ff < 4; ++ff) { const int fi = 4 * w + ff, T = fi >> 2, ks = fi & 3;
        const float* p = ((T < 4) ? wa : wx) + (size_t)hh * 16384 + 64 * j2 + 32 * ((T >> 1) & 1) + 8 * (tl >> 2) + 4 * (T & 1) + (tl & 3) + (size_t)(32 * ks + 8 * g) * 128; v4u u4;
        u4.x = pk2(p[0], p[128]); u4.y = pk2(p[256], p[384]); u4.z = pk2(p[512], p[640]); u4.w = pk2(p[768], p[896]);
        *(LAS v4u*)(wfl + (fi * 64 + lane) * 16) = u4; }
    const int chn = hh * 128 + 64 * j2 + 8 * g;
    float hcl = 0.f;
    __syncthreads();
    lru_issue_x(F, XR, b, hh, 0);
    asm volatile("s_waitcnt vmcnt(0)" ::: "memory"); WG_BAR();
    for (int chunk = 0; chunk < 16; ++chunk) {
        if (chunk < 15) lru_issue_x(F, XR, b, hh, chunk + 1);
        const LAS unsigned char* xb = F.lds + LRU_XBUF + (chunk & 1) * LRU_XBUF_STRIDE + (16 * w + tl) * 256;
        const int t = chunk * 128 + 16 * w + tl; const size_t row = (size_t)b * SEQ + t;
        bf16* yp = XGYL + row * 4096 + chn;
        const v4u gv0 = *(const v4u*)yp, gv1 = *(const v4u*)(yp + 32);
        bf16x8 bfr[4]; float xcf[16];
#pragma unroll
        for (int i = 0; i < 16; ++i) xcf[i] = 0.f;
#pragma unroll
        for (int ks = 0; ks < 4; ++ks) { const int cl = 32 * ks + 8 * g; float a8[8];
            { const f32x4 b0 = *(const LAS f32x4*)(tab + 512 + cl), b1 = *(const LAS f32x4*)(tab + 512 + cl + 4); a8[0] = b0[0]; a8[1] = b0[1]; a8[2] = b0[2]; a8[3] = b0[3]; a8[4] = b1[0]; a8[5] = b1[1]; a8[6] = b1[2]; a8[7] = b1[3]; }
#pragma unroll
            for (int k = 0; k < 4; ++k) { const int rr = 16 * w + tl + k; v4u xq = *(const LAS v4u*)(xb + k * 256 + (((4 * ks + g) ^ (rr & 15)) << 4));
                const bool inb = (chunk > 0) || (rr >= 3); xq.x = inb ? xq.x : 0u; xq.y = inb ? xq.y : 0u; xq.z = inb ? xq.z : 0u; xq.w = inb ? xq.w : 0u;
                const f32x4 w0 = *(const LAS f32x4*)(tab + k * 128 + cl), w1 = *(const LAS f32x4*)(tab + k * 128 + cl + 4);
                a8[0] += w0[0] * pg8::bf_lo(xq.x); a8[1] += w0[1] * pg8::bf_hi(xq.x); a8[2] += w0[2] * pg8::bf_lo(xq.y); a8[3] += w0[3] * pg8::bf_hi(xq.y);
                a8[4] += w1[0] * pg8::bf_lo(xq.z); a8[5] += w1[1] * pg8::bf_hi(xq.z); a8[6] += w1[2] * pg8::bf_lo(xq.w); a8[7] += w1[3] * pg8::bf_hi(xq.w); }
            v4u u4; u4.x = pg8::cvt_pk_bf16(a8[0], a8[1]); u4.y = pg8::cvt_pk_bf16(a8[2], a8[3]); u4.z = pg8::cvt_pk_bf16(a8[4], a8[5]); u4.w = pg8::cvt_pk_bf16(a8[6], a8[7]); bfr[ks] = __builtin_bit_cast(bf16x8, u4);
#pragma unroll
            for (int i = 0; i < 8; ++i) { xcf[i] = (ks == 2 * j2) ? a8[i] : xcf[i]; xcf[8 + i] = (ks == 2 * j2 + 1) ? a8[i] : xcf[8 + i]; } }
        f32x4 pa[8];
#pragma unroll
        for (int T = 0; T < 8; ++T) { pa[T] = (f32x4){0.f, 0.f, 0.f, 0.f};
#pragma unroll
            for (int ks = 0; ks < 4; ++ks) { const bf16x8 wfr = *(const LAS bf16x8*)(wfl + ((T * 4 + ks) * 64 + lane) * 16); pa[T] = __builtin_amdgcn_mfma_f32_16x16x32_bf16(wfr, bfr[ks], pa[T], 0, 0, 0); } }
        float av[16], uv[16];
#pragma unroll
        for (int s2 = 0; s2 < 2; ++s2) {
            const f32x4 ba0 = *(const LAS f32x4*)(ctab + 32 * s2 + 8 * g), ba1 = *(const LAS f32x4*)(ctab + 32 * s2 + 8 * g + 4);
            const f32x4 bx0 = *(const LAS f32x4*)(ctab + 64 + 32 * s2 + 8 * g), bx1 = *(const LAS f32x4*)(ctab + 64 + 32 * s2 + 8 * g + 4);
            const f32x4 sp0 = *(const LAS f32x4*)(ctab + 128 + 32 * s2 + 8 * g), sp1 = *(const LAS f32x4*)(ctab + 128 + 32 * s2 + 8 * g + 4);
#pragma unroll
            for (int i = 0; i < 8; ++i) { const float bai = (i < 4) ? ba0[i & 3] : ba1[i & 3], bxi = (i < 4) ? bx0[i & 3] : bx1[i & 3], spi = (i < 4) ? sp0[i & 3] : sp1[i & 3];
                const float rp = pa[s2 * 2 + (i >> 2)][i & 3] + bai, xp = pa[4 + s2 * 2 + (i >> 2)][i & 3] + bxi;
                const float rr = pg8::fsigmoid(rp), ig = pg8::fsigmoid(xp), la = -spi * rr, x2 = 2.0f * la;
                const float a = __builtin_amdgcn_exp2f(LOG2E * la);
                const float em1 = (x2 > -0.3f) ? x2 * (1.0f + x2 * (0.5f + x2 * (0.16666667f + x2 * (0.041666668f + x2 * 0.0083333333f)))) : (a * a - 1.0f);
                av[8 * s2 + i] = a; uv[8 * s2 + i] = __builtin_amdgcn_sqrtf(-em1) * ig * xcf[8 * s2 + i]; } }
#pragma unroll
        for (int i = 0; i < 16; ++i) {
            { const float ap = row_shr<1>(1.0f, av[i]), up = row_shr<1>(0.0f, uv[i]); uv[i] = fmaf(av[i], up, uv[i]); av[i] *= ap; }
            { const float ap = row_shr<2>(1.0f, av[i]), up = row_shr<2>(0.0f, uv[i]); uv[i] = fmaf(av[i], up, uv[i]); av[i] *= ap; }
            { const float ap = row_shr<4>(1.0f, av[i]), up = row_shr<4>(0.0f, uv[i]); uv[i] = fmaf(av[i], up, uv[i]); av[i] *= ap; }
            { const float ap = row_shr<8>(1.0f, av[i]), up = row_shr<8>(0.0f, uv[i]); uv[i] = fmaf(av[i], up, uv[i]); av[i] *= ap; } }
        LAS float* tb = tot + (chunk & 1) * 1024;
        if (tl == 15) {
#pragma unroll
            for (int i = 0; i < 16; i += 2) *(LAS f32x4*)(tb + (w * 64 + g * 16 + i) * 2) = (f32x4){av[i], uv[i], av[i + 1], uv[i + 1]}; }
        asm volatile("s_waitcnt vmcnt(0)" ::: "memory"); WG_BAR();
        float myh = 0.f;
#pragma unroll
        for (int w2 = 0; w2 < 8; ++w2) { const pg8::f32x2 au = *(const LAS pg8::f32x2*)(tb + (w2 * 64 + g * 16 + tl) * 2);
            myh = (w2 == w) ? hcl : myh; hcl = fmaf(au[0], hcl, au[1]); }
        float y[16];
        y[0] = row_bcast<0>(myh); y[1] = row_bcast<1>(myh); y[2] = row_bcast<2>(myh); y[3] = row_bcast<3>(myh); y[4] = row_bcast<4>(myh); y[5] = row_bcast<5>(myh); y[6] = row_bcast<6>(myh); y[7] = row_bcast<7>(myh);
        y[8] = row_bcast<8>(myh); y[9] = row_bcast<9>(myh); y[10] = row_bcast<10>(myh); y[11] = row_bcast<11>(myh); y[12] = row_bcast<12>(myh); y[13] = row_bcast<13>(myh); y[14] = row_bcast<14>(myh); y[15] = row_bcast<15>(myh);
#pragma unroll
        for (int i = 0; i < 16; ++i) y[i] = av[i] * y[i] + uv[i];
        y[0] *= pg8::bf_lo(gv0.x); y[1] *= pg8::bf_hi(gv0.x); y[2] *= pg8::bf_lo(gv0.y); y[3] *= pg8::bf_hi(gv0.y); y[4] *= pg8::bf_lo(gv0.z); y[5] *= pg8::bf_hi(gv0.z); y[6] *= pg8::bf_lo(gv0.w); y[7] *= pg8::bf_hi(gv0.w);
        y[8] *= pg8::bf_lo(gv1.x); y[9] *= pg8::bf_hi(gv1.x); y[10] *= pg8::bf_lo(gv1.y); y[11] *= pg8::bf_hi(gv1.y); y[12] *= pg8::bf_lo(gv1.z); y[13] *= pg8::bf_hi(gv1.z); y[14] *= pg8::bf_lo(gv1.w); y[15] *= pg8::bf_hi(gv1.w);
        v4u o0, o1; o0.x = pg8::cvt_pk_bf16(y[0], y[1]); o0.y = pg8::cvt_pk_bf16(y[2], y[3]); o0.z = pg8::cvt_pk_bf16(y[4], y[5]); o0.w = pg8::cvt_pk_bf16(y[6], y[7]);
        o1.x = pg8::cvt_pk_bf16(y[8], y[9]); o1.y = pg8::cvt_pk_bf16(y[10], y[11]); o1.z = pg8::cvt_pk_bf16(y[12], y[13]); o1.w = pg8::cvt_pk_bf16(y[14], y[15]);
        *(v4u*)yp = o0; *(v4u*)(yp + 32) = o1;
    }
}

struct Args { const float* in[17]; float* out; unsigned char* ws; int ph_lo, ph_hi; };

__global__ void __launch_bounds__(NWAVES * 64, 2) mega(Args args) {
    extern __shared__ __attribute__((aligned(16))) unsigned char lds[];
    Frame F;
    F.lds = (LAS unsigned char*)lds;
    F.tid = threadIdx.x; F.lane = F.tid & 63; F.wave = __builtin_amdgcn_readfirstlane(F.tid >> 6);
    F.G = gridDim.x; { const int bx = blockIdx.x; F.vcu = (F.G % 8 == 0) ? (bx % 8) * (F.G / 8) + bx / 8 : bx; }
    unsigned char* ws = args.ws; unsigned char* dout = (unsigned char*)args.out;
    const float* x = args.in[0];
    const int lo = args.ph_lo, hi = args.ph_hi;
    volatile LAS unsigned* MISC = (volatile LAS unsigned*)(F.lds + MISC_OFF);
    if (F.tid < 32) MISC[F.tid] = 0u;
    __syncthreads();
    XcdBarrier bar; bar.bar = (unsigned*)(ws + WS_CTL) + CW_BAR; bar.x = 0; bar.st = nullptr;
    if (hi - lo > 1) bar = xcd_barrier_post((unsigned*)(ws + WS_CTL) + CW_BAR, MISC + 8);
    if (hi > 1000) cg::this_grid().sync();
#define IN(k) (lo <= (k) && (k) < hi)
#define SYNC(k) do { if (IN(k) && IN((k) + 1)) { xcd_barrier(bar); } } while (0)
    const int gw = F.vcu * NWAVES + F.wave, NGW = F.G * NWAVES;
    bf16* XNL = (bf16*)dout;
    bf16* XGR = (bf16*)dout + 2048;

    if (IN(0)) {
        for (int i = blockIdx.x * 512 + F.tid; i < 2 * M; i += F.G * 512) ((float*)(ws + WS_RSS1))[i] = 0.f;
        transpose_all(F, args.in[2], D, INC, (bf16*)(ws + WS_WIN));
        transpose_all(F, args.in[10], D, D, (bf16*)(ws + WS_WPA));
        transpose_all(F, args.in[11], D, D, (bf16*)(ws + WS_WPL));
        transpose_all(F, args.in[12], D, D, (bf16*)(ws + WS_WOUT));
        transpose_all(F, args.in[14], D, FF, (bf16*)(ws + WS_WUP));
        for (int m = gw; m < M; m += NGW) rms_row_to_bf16(F, x + (size_t)m * D, args.in[1], XNL + (size_t)m * 4096);
    }
    SYNC(0);
    int ceff = (int)blockIdx.x;
    if (IN(0) && IN(1)) {
        if (F.tid == 0) { unsigned okk = (F.G % 8 == 0) ? 1u : 0u;
            for (unsigned j = 0; j < 16; ++j) { const unsigned c = xb_ld(&bar.bar[XB_XCNT(j)]); okk &= (c == (j < 8 ? (unsigned)F.G / 8u : 0u)) ? 1u : 0u; }
            MISC[12] = okk; }
        __syncthreads();
        if (MISC[12] != 0u) { const int xid = (int)MISC[11], loc = (int)MISC[10]; ceff = xid + 8 * loc; F.vcu = xid * (F.G / 8) + loc; }
    }
    if (IN(1)) {
        pg8::Gemm g{XNL, (const bf16*)(ws + WS_WIN), M, INC, D, 4096, 0}; pg8::StaticOrder S; S.init(M, INC, F.G, ceff);
        pg8::EpiProj E{(bf16*)(ws + WS_Q), XGR, (bf16*)(ws + WS_GA), QSCALE};
        pg8::gemm_phase<pg8::EpiProj, pg8::StaticOrder, PG8_ALIGN, PG8_SP2>(F.lds, g, S, E);
    }
    SYNC(1);
    if (IN(2)) {
#if !USE_NAIVE_LRU
        for (int it = F.vcu; it < 256; it += F.G) lru_item(F, (const bf16*)(ws + WS_XR), XGR, args.in[3], args.in[4], args.in[5], args.in[6], args.in[7], args.in[8], args.in[9], it >> 5, (it >> 1) & 15, it & 1);
#endif
#if !USE_NAIVE_ATTN
        { const DecP2 dec{XNL, (bf16*)(ws + WS_O3), (float*)(ws + WS_LSE2), (float*)(ws + WS_LSE3)};
          attn_phase<0, DecP2>(F, (const bf16*)(ws + WS_Q), (const bf16*)(ws + WS_K), (const bf16*)(ws + WS_V), 4096, dec, nullptr, nullptr, nullptr); }
#endif
    }
    SYNC(2);
    if (IN(3)) {
#if !USE_NAIVE_ATTN
        { const DecP3 dec{XNL};
          attn_phase<1, DecP3>(F, (const bf16*)(ws + WS_Q), (const bf16*)(ws + WS_K), (const bf16*)(ws + WS_V), 2048, dec, (const bf16*)(ws + WS_O3), (const float*)(ws + WS_LSE2), (const float*)(ws + WS_LSE3)); }
#endif
    }
    SYNC(3);
    if (IN(4)) {
        transpose_all(F, args.in[15], FF, D, (bf16*)(ws + WS_WDN));
        __syncthreads();
        { pg8::Gemm g{XNL, (const bf16*)(ws + WS_WPA), M, D, D, 4096, 0}; pg8::StaticOrder S; S.init(M, D, F.G, ceff);
          pg8::EpiGate<0> E{(const bf16*)(ws + WS_GA), (bf16*)(ws + WS_MRG)};
          pg8::gemm_phase<pg8::EpiGate<0>, pg8::StaticOrder, PG8_ALIGN, PG8_SP2>(F.lds, g, S, E); }
        VM_WAIT(); __syncthreads();
        { pg8::Gemm g{XGR, (const bf16*)(ws + WS_WPL), M, D, D, 4096, 0}; pg8::StaticOrder S; S.init(M, D, F.G, ceff);
          pg8::EpiGate<1> E{(const bf16*)(ws + WS_GL), (bf16*)(ws + WS_MRG)};
          pg8::gemm_phase<pg8::EpiGate<1>, pg8::StaticOrder, PG8_ALIGN, PG8_SP2>(F.lds, g, S, E); }
    }
    SYNC(4);
    if (IN(5)) {
        pg8::Gemm g{(const bf16*)(ws + WS_MRG), (const bf16*)(ws + WS_WOUT), M, D, D, D, 0}; pg8::StaticOrder S; S.init(M, D, F.G, ceff);
        pg8::EpiRes<true> E{x, args.out, (bf16*)(ws + WS_A5), args.in[13], (float*)(ws + WS_RSS1)};
        pg8::gemm_phase<pg8::EpiRes<true>, pg8::StaticOrder, PG8_ALIGN, PG8_SP2>(F.lds, g, S, E);
    }
    SYNC(5);
    if (IN(6)) {
        pg8::Gemm g{(const bf16*)(ws + WS_A5), (const bf16*)(ws + WS_WUP), M, FF, D, D, 0}; pg8::StaticOrder S; S.init(M, FF, F.G, ceff);
        pg8::EpiUp E{(const float*)(ws + WS_RSS1), (bf16*)(ws + WS_HID)};
        pg8::gemm_phase<pg8::EpiUp, pg8::StaticOrder, PG8_ALIGN, PG8_SP2>(F.lds, g, S, E);
    }
    SYNC(6);
    if (IN(7)) {
        pg8::Gemm g{(const bf16*)(ws + WS_HID), (const bf16*)(ws + WS_WDN), M, D, FF, FF, 1}; pg8::StaticOrder S; S.init(M, D, F.G, ceff);
        pg8::EpiRes<false> E{args.out, args.out, nullptr, nullptr, (float*)(ws + WS_RSS2)};
        pg8::gemm_phase<pg8::EpiRes<false>, pg8::StaticOrder, PG8_ALIGN, PG8_SP2>(F.lds, g, S, E);
    }
    SYNC(7);
    if (IN(8)) {
        const float* rss = (const float*)(ws + WS_RSS2); const GAS f32x4* gr = (const GAS f32x4*)args.in[16] + F.lane;
        for (int m = gw; m < M; m += NGW) { const float rstd = 1.f / sqrtf(rss[m] * (1.f / D) + EPS); GAS f32x4* o = (GAS f32x4*)(args.out + (size_t)m * D) + F.lane;
#pragma unroll
            for (int j = 0; j < 8; ++j) { const f32x4 gg = gr[64 * j]; f32x4 v = o[64 * j]; v = v * rstd; v.x *= gg.x; v.y *= gg.y; v.z *= gg.z; v.w *= gg.w; o[64 * j] = v; } }
    }
#undef IN
#undef SYNC
}

extern "C" void kernel_launch(void* const* d_in, const int* in_sizes, int n_in, void* d_out, int out_size, void* d_ws, size_t ws_size, hipStream_t stream) {
    static int grid = 0;
    if (grid == 0) {
        if (n_in != 17 || out_size != M * D || ws_size < WS_END) { fprintf(stderr, "kernel_launch: unexpected shapes: n_in %d out %d ws %zu\n", n_in, out_size, ws_size); grid = -1; return; }
        int dev = 0, cus = 0;
        hipGetDevice(&dev); hipDeviceGetAttribute(&cus, hipDeviceAttributeMultiprocessorCount, dev);
        hipFuncSetAttribute((const void*)mega, hipFuncAttributeMaxDynamicSharedMemorySize, LDS_BYTES);
        grid = cus > 0 ? cus : 256;
    }
    if (grid < 0) return;
    Args a{};
    for (int i = 0; i < 17; ++i) a.in[i] = (const float*)d_in[i];
    a.out = (float*)d_out; a.ws = (unsigned char*)d_ws;
    unsigned char* ws = (unsigned char*)d_ws;
#if ONE_LAUNCH
    a.ph_lo = 0; a.ph_hi = 9;
    if (hipMemsetAsync((char*)d_ws + WS_CTL, 0, CTL_ZERO_BYTES, stream) != hipSuccess) { fprintf(stderr, "memset of control words failed\n"); return; }
    void* kargs[] = {&a};
    hipError_t e = hipLaunchCooperativeKernel((const void*)mega, dim3(grid), dim3(NWAVES * 64), kargs, LDS_BYTES, stream);
    if (e != hipSuccess) fprintf(stderr, "cooperative launch failed: %s (grid %d)\n", hipGetErrorString(e), grid);
#else
    auto launch = [&](int lo, int hi) { a.ph_lo = lo; a.ph_hi = hi; hipLaunchKernelGGL(mega, dim3(grid), dim3(NWAVES * 64), LDS_BYTES, stream, a); };
    launch(0, 1); launch(1, 2); launch(2, 3);
    launch(3, 4);
    launch(4, 5); launch(5, 6); launch(6, 7); launch(7, 8); launch(8, 9);
#endif
}
```

```cpp
#include <hip/hip_runtime.h>
#include <cstdio>
#include <cstdint>
#include <cmath>
#include <hip/hip_cooperative_groups.h>
namespace cg = cooperative_groups;
namespace pg8 {
#define PG8_LAS __attribute__((address_space(3)))
typedef unsigned short bf16_t;
typedef short bf16x8 __attribute__((ext_vector_type(8)));
typedef float f32x4 __attribute__((ext_vector_type(4)));
typedef unsigned u32x4 __attribute__((ext_vector_type(4)));
constexpr int BM = 256, BK = 64, HALF = 128, HTB = HALF * BK * 2  , STAGE_BYTES = 8 * HTB, NXCD = 8, WGM = 8;

__host__ __device__ __forceinline__ int lds_byte(int r, int c) { const int st = (r >> 4) * 2 + (c >> 5), rr = r & 15, cc = c & 31, ob = rr * 64 + cc * 2; return st * 1024 + (ob ^ (((ob >> 9) & 1) << 5)); }
__host__ __device__ __forceinline__ void stage_rc(int b, int& R, int& C) { const int st = b / 1024, sb = b % 1024, swz = sb ^ (((sb >> 9) & 1) << 5); R = (st >> 1) * 16 + swz / 64; C = (st & 1) * 32 + (swz % 64) / 2; }
__host__ __device__ __forceinline__ int perm32(int rho) { const int n = rho >> 4, i = rho & 15; return 8 * (i >> 2) + 4 * n + (i & 3); }

struct Unit { int pm, pn; };
struct Gemm { const bf16_t* A; const bf16_t* Bt; int M, N, K, lda; };

struct StaticOrder {
    int nM, nN, nwg, G, c;
    __host__ __device__ void init(int M, int N, int G_, int c_) { nM = M / BM; nN = N / BM; nwg = nM * nN; G = G_; c = c_; }
    __host__ __device__ bool next(int i, Unit& u) const {
        const long L = (long)i * G + c; if (L >= nwg) return false;
        int wgid = (int)L; { const int q = nwg / NXCD, r = nwg % NXCD, xcd = wgid % NXCD, off = wgid / NXCD; wgid = (xcd < r ? xcd * (q + 1) : r * (q + 1) + (xcd - r) * q) + off; }
        const int nig = WGM * nN, gid = wgid / nig, fm = gid * WGM, gsz = (nM - fm) < WGM ? (nM - fm) : WGM;
        u.pm = fm + ((wgid % nig) % gsz); u.pn = (wgid % nig) / gsz; return true;
    }
    __device__ __forceinline__ void a_ready(const Unit&) const {}
    __device__ __forceinline__ void done(const Unit&) const {}
};
__device__ __forceinline__ unsigned cvt_pk_bf16(float lo, float hi) { unsigned r; asm volatile("v_cvt_pk_bf16_f32 %0, %1, %2" : "=v"(r) : "v"(lo), "v"(hi)); return r; }
typedef float f32x2 __attribute__((ext_vector_type(2)));
typedef unsigned u32x2 __attribute__((ext_vector_type(2)));
__device__ __forceinline__ float bf_lo(unsigned w) { return __uint_as_float(w << 16); }
__device__ __forceinline__ float bf_hi(unsigned w) { return __uint_as_float(w & 0xffff0000u); }
__device__ __forceinline__ float fsigmoid(float x) { return __builtin_amdgcn_rcpf(1.0f + __builtin_amdgcn_exp2f(-1.4426950408889634f * x)); }
__device__ __forceinline__ float fgelu(float x) { const float z = x * (1.0f + 0.044715f * x * x); return x * __builtin_amdgcn_rcpf(1.0f + __builtin_amdgcn_exp2f(-2.0f * 0.7978845608028654f * 1.4426950408889634f * z)); }
constexpr size_t SEG_ELEMS = (size_t)16384 * 2048;

struct EpiProj {
    static constexpr bool PERM = true, AFTER_DRAIN = false;
    bf16_t* seg03; bf16_t* xg; bf16_t* gates; float qscale;
    __device__ __forceinline__ void operator()(const f32x4 (&acc)[2][2][4][2], const Unit& u, int wr, int wc, int fr, int fq) const {
        const int seg = u.pn >> 3, colt = (u.pn & 7) * BM;
        bf16_t* base; int ldc;
        if (seg < 4) { base = seg03 + (size_t)seg * SEG_ELEMS; ldc = 2048; } else if (seg == 4) { base = xg; ldc = 4096; } else { base = gates + (size_t)(seg - 5) * SEG_ELEMS; ldc = 2048; }
        const float sc = (seg == 0) ? qscale : 1.f; const bool sig = seg >= 5, gel = seg == 4;
        const int row0 = u.pm * BM + wr * 64 + fr, col0 = colt + wc * 32 + 8 * fq;
#pragma unroll
        for (int ai = 0; ai < 2; ++ai)
#pragma unroll
            for (int m = 0; m < 4; ++m) { bf16_t* rowp = base + (size_t)(row0 + ai * HALF + m * 16) * ldc + col0;
#pragma unroll
                for (int bj = 0; bj < 2; ++bj) { f32x4 v0 = acc[ai][bj][m][0], v1 = acc[ai][bj][m][1];
                    if (sig) {
#pragma unroll
                        for (int e = 0; e < 4; ++e) { v0[e] = fsigmoid(v0[e]); v1[e] = fsigmoid(v1[e]); } }
                    else if (gel) {
#pragma unroll
                        for (int e = 0; e < 4; ++e) { v0[e] = fgelu(v0[e]); v1[e] = fgelu(v1[e]); } }
                    else { v0 = v0 * sc; v1 = v1 * sc; }
                    u32x4 w; w.x = cvt_pk_bf16(v0[0], v0[1]); w.y = cvt_pk_bf16(v0[2], v0[3]); w.z = cvt_pk_bf16(v1[0], v1[1]); w.w = cvt_pk_bf16(v1[2], v1[3]);
                    *(u32x4*)(rowp + bj * HALF) = w; } }
    }
};
template <int MODE> struct EpiGate {
    static constexpr bool PERM = true, AFTER_DRAIN = false;
    const bf16_t* G; bf16_t* O;
    __device__ __forceinline__ void operator()(const f32x4 (&acc)[2][2][4][2], const Unit& u, int wr, int wc, int fr, int fq) const {
        const int row0 = u.pm * BM + wr * 64 + fr, col0 = u.pn * BM + wc * 32 + 8 * fq;
#pragma unroll
        for (int ai = 0; ai < 2; ++ai)
#pragma unroll
            for (int m = 0; m < 4; ++m) { const size_t ro = (size_t)(row0 + ai * HALF + m * 16) * 2048 + col0;
#pragma unroll
                for (int bj = 0; bj < 2; ++bj) { const size_t off = ro + bj * HALF; const u32x4 g = *(const u32x4*)(G + off);
                    f32x4 v0 = acc[ai][bj][m][0], v1 = acc[ai][bj][m][1];
                    v0[0] *= bf_lo(g.x); v0[1] *= bf_hi(g.x); v0[2] *= bf_lo(g.y); v0[3] *= bf_hi(g.y); v1[0] *= bf_lo(g.z); v1[1] *= bf_hi(g.z); v1[2] *= bf_lo(g.w); v1[3] *= bf_hi(g.w);
                    if (MODE == 1) { const u32x4 p = *(const u32x4*)(O + off);
                        v0[0] += bf_lo(p.x); v0[1] += bf_hi(p.x); v0[2] += bf_lo(p.y); v0[3] += bf_hi(p.y); v1[0] += bf_lo(p.z); v1[1] += bf_hi(p.z); v1[2] += bf_lo(p.w); v1[3] += bf_hi(p.w); }
                    u32x4 w; w.x = cvt_pk_bf16(v0[0], v0[1]); w.y = cvt_pk_bf16(v0[2], v0[3]); w.z = cvt_pk_bf16(v1[0], v1[1]); w.w = cvt_pk_bf16(v1[2], v1[3]);
                    *(u32x4*)(O + off) = w; } }
    }
};
template <bool WITH_A5> struct EpiRes {
    static constexpr bool PERM = false, AFTER_DRAIN = false;
    const float* R; float* H; bf16_t* a5; const float* gm; float* rowss;
    __device__ __forceinline__ void operator()(const f32x4 (&acc)[2][2][4][2], const Unit& u, int wr, int wc, int fr, int fq) const {
        const int row0 = u.pm * BM + wr * 64 + fr, col0 = u.pn * BM + wc * 32 + 4 * fq;
#pragma unroll
        for (int ai = 0; ai < 2; ++ai)
#pragma unroll
            for (int m = 0; m < 4; ++m) { const int row = row0 + ai * HALF + m * 16; const size_t ro = (size_t)row * 2048 + col0; float ss = 0.f;
#pragma unroll
                for (int bj = 0; bj < 2; ++bj)
#pragma unroll
                    for (int n = 0; n < 2; ++n) { const size_t off = ro + bj * HALF + n * 16; const f32x4 hv = *(const f32x4*)(R + off) + acc[ai][bj][m][n];
                        *(f32x4*)(H + off) = hv; ss += (hv[0] * hv[0] + hv[1] * hv[1]) + (hv[2] * hv[2] + hv[3] * hv[3]);
                        if (WITH_A5) { const f32x4 gv = *(const f32x4*)(gm + col0 + bj * HALF + n * 16); u32x2 w; w.x = cvt_pk_bf16(hv[0] * gv[0], hv[1] * gv[1]); w.y = cvt_pk_bf16(hv[2] * gv[2], hv[3] * gv[3]); *(u32x2*)(a5 + off) = w; } }
                ss += __shfl_xor(ss, 16); ss += __shfl_xor(ss, 32);
                if (fq == 0) atomicAdd(rowss + row, ss); }
    }
};
struct EpiUp {
    static constexpr bool PERM = true, AFTER_DRAIN = false;
    const float* rowss; bf16_t* O;
    __device__ __forceinline__ void operator()(const f32x4 (&acc)[2][2][4][2], const Unit& u, int wr, int wc, int fr, int fq) const {
        const int row0 = u.pm * BM + wr * 64 + fr, col0 = u.pn * BM + wc * 32 + 8 * fq;
#pragma unroll
        for (int ai = 0; ai < 2; ++ai)
#pragma unroll
            for (int m = 0; m < 4; ++m) { const int row = row0 + ai * HALF + m * 16; const float rs = 1.0f / sqrtf(rowss[row] * (1.0f / 2048.0f) + 1e-6f); bf16_t* rowp = O + (size_t)row * 8192 + col0;
#pragma unroll
                for (int bj = 0; bj < 2; ++bj) { f32x4 v0 = acc[ai][bj][m][0] * rs, v1 = acc[ai][bj][m][1] * rs;
#pragma unroll
                    for (int e = 0; e < 4; ++e) { const float a = fmaxf(v0[e], 0.f), b = fmaxf(v1[e], 0.f); v0[e] = a * a; v1[e] = b * b; }
                    u32x4 w; w.x = cvt_pk_bf16(v0[0], v0[1]); w.y = cvt_pk_bf16(v0[2], v0[3]); w.z = cvt_pk_bf16(v1[0], v1[1]); w.w = cvt_pk_bf16(v1[2], v1[3]);
                    *(u32x4*)(rowp + bj * HALF) = w; } }
    }
};

template <class Epi, class Sched, bool ALIGN_EPI = false, bool SP2 = false>
__device__ __forceinline__ void gemm_phase(PG8_LAS unsigned char* lds, const Gemm g, const Sched& S, const Epi& E) {
    const int tid = threadIdx.x, wid = __builtin_amdgcn_readfirstlane(tid >> 6), lane = tid & 63, wr = wid >> 2, wc = wid & 3, fr = lane & 15, fq = lane >> 4;
    const int K = g.K, nt = K / BK;
    unsigned voffA[2], voffB[2];
#pragma unroll
    for (int i = 0; i < 2; ++i) { int R, C; stage_rc(tid * 16 + i * 8192, R, C); const int Rb = Epi::PERM ? ((R & ~31) + perm32(R & 31)) : R;
        voffA[i] = (unsigned)(R * g.lda + C) * 2u; voffB[i] = (unsigned)(Rb * K + C) * 2u; }
    const size_t kstep = (size_t)(BK * 2);
    const size_t hstepA = (size_t)HALF * g.lda * 2, hstepB = (size_t)HALF * K * 2;
    const size_t tstepA = 2 * hstepA, tstepB = 2 * hstepB;
    const unsigned ldsw = (unsigned)wid * 1024u;
    const int aoff = lds_byte(wr * 64 + fr, fq * 8), boff = lds_byte(wc * 32 + fr, fq * 8);
#define PG8_SA(b, h) (((b) * 2 + (h)) * HTB)
#define PG8_SB(b, h) ((4 + (b) * 2 + (h)) * HTB)
#define PG8_STAGE(bufoff, gbase, voff) do { _Pragma("unroll") for (int _i = 0; _i < 2; ++_i) \
        __builtin_amdgcn_global_load_lds((const unsigned*)((const char*)(gbase) + (voff)[_i]), (PG8_LAS unsigned*)(lds + (bufoff) + ldsw + _i * 8192), 16, 0, 0); } while (0)
#define PG8_LDA(dst, b, h) do { _Pragma("unroll") for (int m = 0; m < 4; ++m) _Pragma("unroll") for (int k = 0; k < 2; ++k) dst[m][k] = *(const PG8_LAS bf16x8*)(lds + PG8_SA(b, h) + aoff + m * 2048 + k * 1024); } while (0)
#define PG8_LDB(dst, b, h) do { _Pragma("unroll") for (int n = 0; n < 2; ++n) _Pragma("unroll") for (int k = 0; k < 2; ++k) dst[n][k] = *(const PG8_LAS bf16x8*)(lds + PG8_SB(b, h) + boff + n * 2048 + k * 1024); } while (0)
#define PG8_MMA(ai, bj, At, Bt) do { __builtin_amdgcn_s_setprio(1); _Pragma("unroll") for (int m = 0; m < 4; ++m) _Pragma("unroll") for (int n = 0; n < 2; ++n) _Pragma("unroll") for (int k = 0; k < 2; ++k) \
        acc[ai][bj][m][n] = __builtin_amdgcn_mfma_f32_16x16x32_bf16(Bt[n][k], At[m][k], acc[ai][bj][m][n], 0, 0, 0); __builtin_amdgcn_s_setprio(0); } while (0)
#define PG8_WAIT_V(n) asm volatile("s_waitcnt vmcnt(" #n ")" ::: "memory")
#define PG8_WAIT_L(n) asm volatile("s_waitcnt lgkmcnt(" #n ")" ::: "memory")
#define PG8_BAR __builtin_amdgcn_s_barrier()
#define PG8_SCHED __builtin_amdgcn_sched_barrier(0)
    Unit cur, nxt; int ui = 0;
    if (!S.next(0, cur)) return;
    f32x4 acc[2][2][4][2];
#pragma unroll
    for (int a = 0; a < 2; ++a)
#pragma unroll
        for (int b = 0; b < 2; ++b)
#pragma unroll
            for (int m = 0; m < 4; ++m)
#pragma unroll
                for (int n = 0; n < 2; ++n) acc[a][b][m][n] = (f32x4){0.f, 0.f, 0.f, 0.f};
    bf16x8 At[4][2], B0[2][2], B1[2][2];
    const char* cA = (const char*)g.A + (size_t)cur.pm * tstepA; const char* cB = (const char*)g.Bt + (size_t)cur.pn * tstepB;
    S.a_ready(cur);
    if constexpr (SP2) {
        PG8_STAGE(PG8_SB(0, 0), cB, voffB); PG8_STAGE(PG8_SB(0, 1), cB + hstepB, voffB); PG8_STAGE(PG8_SA(0, 0), cA, voffA); PG8_STAGE(PG8_SA(0, 1), cA + hstepA, voffA);
        if (wr == 1) PG8_BAR;
        PG8_WAIT_V(2); PG8_BAR;
        PG8_STAGE(PG8_SB(1, 0), cB + kstep, voffB); PG8_STAGE(PG8_SA(1, 0), cA + kstep, voffA); PG8_STAGE(PG8_SB(1, 1), cB + hstepB + kstep, voffB);
        PG8_WAIT_V(6); PG8_BAR;
    } else {
        PG8_STAGE(PG8_SB(0, 0), cB, voffB); PG8_STAGE(PG8_SA(0, 0), cA, voffA); PG8_STAGE(PG8_SB(0, 1), cB + hstepB, voffB); PG8_STAGE(PG8_SA(0, 1), cA + hstepA, voffA);
        if (wr == 1) PG8_BAR;
        PG8_WAIT_V(4); PG8_BAR;
        PG8_STAGE(PG8_SB(1, 0), cB + kstep, voffB); PG8_STAGE(PG8_SA(1, 0), cA + kstep, voffA); PG8_STAGE(PG8_SB(1, 1), cB + hstepB + kstep, voffB);
        PG8_WAIT_V(6); PG8_BAR;
    }
    for (;;) {
        const bool has_next = S.next(ui + 1, nxt);
        const char* nA = has_next ? (const char*)g.A + (size_t)nxt.pm * tstepA : cA; const char* nB = has_next ? (const char*)g.Bt + (size_t)nxt.pn * tstepB : cB;
        for (int t = 0; t < nt; t += 2) {
            const bool last = (t == nt - 2);
            const char* a1 = cA + (size_t)(t + 1) * kstep;
            const char* a2 = last ? nA : cA + (size_t)(t + 2) * kstep; const char* b2 = last ? nB : cB + (size_t)(t + 2) * kstep;
            const char* a3 = a2 + kstep; const char* b3 = b2 + kstep;
            if (last && has_next) S.a_ready(nxt);
            if constexpr (SP2) {
            PG8_LDB(B0, 0, 0); PG8_LDB(B1, 0, 1); PG8_SCHED; PG8_LDA(At, 0, 0); PG8_STAGE(PG8_SA(1, 1), a1 + hstepA, voffA);
            PG8_WAIT_V(8); PG8_WAIT_L(0); PG8_BAR; PG8_MMA(0, 0, At, B0); PG8_MMA(0, 1, At, B1); PG8_BAR; PG8_SCHED;
            PG8_LDA(At, 0, 1); PG8_STAGE(PG8_SB(0, 0), b2, voffB); PG8_STAGE(PG8_SB(0, 1), b2 + hstepB, voffB); PG8_STAGE(PG8_SA(0, 0), a2, voffA);
            PG8_WAIT_V(8); PG8_WAIT_L(0); PG8_BAR; PG8_MMA(1, 0, At, B0); PG8_MMA(1, 1, At, B1); PG8_BAR; PG8_SCHED;
            PG8_LDB(B0, 1, 0); PG8_LDB(B1, 1, 1); PG8_SCHED; PG8_LDA(At, 1, 0); PG8_STAGE(PG8_SA(0, 1), a2 + hstepA, voffA);
            PG8_WAIT_V(8); PG8_WAIT_L(0); PG8_BAR; PG8_MMA(0, 0, At, B0); PG8_MMA(0, 1, At, B1); PG8_BAR; PG8_SCHED;
            PG8_LDA(At, 1, 1); PG8_STAGE(PG8_SB(1, 0), b3, voffB); PG8_STAGE(PG8_SB(1, 1), b3 + hstepB, voffB); PG8_STAGE(PG8_SA(1, 0), a3, voffA);
            PG8_WAIT_V(8); PG8_WAIT_L(0); PG8_BAR; PG8_MMA(1, 0, At, B0); PG8_MMA(1, 1, At, B1); PG8_BAR; PG8_SCHED;
            } else {
            PG8_LDB(B0, 0, 0); PG8_SCHED; PG8_LDA(At, 0, 0); PG8_STAGE(PG8_SA(1, 1), a1 + hstepA, voffA);
            PG8_WAIT_L(8); PG8_BAR; PG8_WAIT_L(0); PG8_MMA(0, 0, At, B0); PG8_BAR; PG8_SCHED;
            PG8_LDB(B1, 0, 1); PG8_STAGE(PG8_SB(0, 0), b2, voffB);
            PG8_BAR; PG8_WAIT_L(0); PG8_MMA(0, 1, At, B1); PG8_BAR;
            PG8_LDA(At, 0, 1); PG8_STAGE(PG8_SA(0, 0), a2, voffA);
            PG8_BAR; PG8_WAIT_L(0); PG8_MMA(1, 0, At, B0); PG8_BAR; PG8_SCHED;
            PG8_STAGE(PG8_SB(0, 1), b2 + hstepB, voffB);
            PG8_WAIT_V(6); PG8_BAR; PG8_MMA(1, 1, At, B1); PG8_BAR;
            PG8_LDB(B0, 1, 0); PG8_SCHED; PG8_LDA(At, 1, 0); PG8_STAGE(PG8_SA(0, 1), a2 + hstepA, voffA);
            PG8_WAIT_L(8); PG8_BAR; PG8_WAIT_L(0); PG8_MMA(0, 0, At, B0); PG8_BAR; PG8_SCHED;
            PG8_LDB(B1, 1, 1); PG8_STAGE(PG8_SB(1, 0), b3, voffB);
            PG8_BAR; PG8_WAIT_L(0); PG8_MMA(0, 1, At, B1); PG8_BAR;
            PG8_LDA(At, 1, 1); PG8_STAGE(PG8_SA(1, 0), a3, voffA);
            PG8_BAR; PG8_WAIT_L(0); PG8_MMA(1, 0, At, B0); PG8_BAR; PG8_SCHED;
            PG8_STAGE(PG8_SB(1, 1), b3 + hstepB, voffB);
            PG8_WAIT_V(6); PG8_BAR; PG8_MMA(1, 1, At, B1); PG8_BAR;
            }
        }
        if constexpr (ALIGN_EPI) { if (wr == 0) PG8_BAR; }
        if constexpr (!Epi::AFTER_DRAIN) { E(acc, cur, wr, wc, fr, fq); S.done(cur); }
        if (!has_next) break;
#pragma unroll
        for (int a = 0; a < 2; ++a)
#pragma unroll
            for (int b = 0; b < 2; ++b)
#pragma unroll
                for (int m = 0; m < 4; ++m)
#pragma unroll
                    for (int n = 0; n < 2; ++n) acc[a][b][m][n] = (f32x4){0.f, 0.f, 0.f, 0.f};
        cur = nxt; cA = nA; cB = nB; ++ui;
        if constexpr (ALIGN_EPI) { if (wr == 1) PG8_BAR; }
    }
    PG8_WAIT_V(0);
    if constexpr (!ALIGN_EPI) { if (wr == 0) PG8_BAR; }
    PG8_BAR;
    if constexpr (Epi::AFTER_DRAIN) { E.fused(acc, cur, wr, wc, fr, fq, lds, wid, lane); S.done(cur); }
#undef PG8_SA
#undef PG8_SB
#undef PG8_STAGE
#undef PG8_LDA
#undef PG8_LDB
#undef PG8_MMA
#undef PG8_WAIT_V
#undef PG8_WAIT_L
#undef PG8_BAR
#undef PG8_SCHED
}
}
#ifndef ONE_LAUNCH
#define ONE_LAUNCH 1
#endif
#ifndef USE_NAIVE_ATTN
#define USE_NAIVE_ATTN 0
#endif
#ifndef USE_NAIVE_LRU
#define USE_NAIVE_LRU 0
#endif
#ifndef PG8_SP2
#define PG8_SP2 true
#endif
#ifndef PG8_ALIGN
#define PG8_ALIGN true
#endif
constexpr int NWAVES = 8;
constexpr int BATCH = 8, SEQ = 2048, D = 2048, NH = 16, HD = 128, FF = 8192, INC = 14336;
constexpr int M = BATCH * SEQ;
constexpr float EPS = 1e-6f;
constexpr float LOG2E = 1.4426950408889634f;
constexpr float QSCALE = 0.08838834764831845f * LOG2E;
constexpr size_t MiB = 1u << 20;
constexpr size_t WS_CTL = 0, WS_RSS1 = 1 * MiB, WS_RSS2 = 1 * MiB + 65536, WS_LSE2 = 2 * MiB, WS_LSE3 = 3 * MiB;
constexpr size_t WS_WPA = 8 * MiB, WS_WPL = 16 * MiB, WS_WOUT = 24 * MiB;
constexpr size_t WS_WIN = 32 * MiB;
constexpr size_t WS_O3 = 32 * MiB, WS_A5 = 32 * MiB;
constexpr size_t WS_Q = 96 * MiB, WS_K = 160 * MiB, WS_V = 224 * MiB, WS_XR = 288 * MiB, WS_GA = 352 * MiB, WS_GL = 416 * MiB;
constexpr size_t WS_WUP = 480 * MiB;
constexpr size_t WS_MRG = 96 * MiB;
constexpr size_t WS_WDN = 160 * MiB;
constexpr size_t WS_HID = 224 * MiB;
constexpr size_t WS_END = 512 * MiB;
constexpr int RING_BYTES = 131072, MISC_OFF = RING_BYTES, LDS_BYTES = 147456;
constexpr size_t CTL_ZERO_BYTES = 65536; constexpr int CW_BAR = 4096;

#define GAS __attribute__((address_space(1)))
#define LAS __attribute__((address_space(3)))
typedef unsigned short bf16;
typedef unsigned v4u __attribute__((ext_vector_type(4)));
typedef unsigned v2u __attribute__((ext_vector_type(2)));
typedef float f32x4 __attribute__((ext_vector_type(4)));
typedef short bf16x8 __attribute__((ext_vector_type(8)));
#define LDS_WAIT() asm volatile("s_waitcnt lgkmcnt(0)" ::: "memory")
#define VM_WAIT() asm volatile("s_waitcnt vmcnt(0)" ::: "memory")
__device__ __forceinline__ unsigned f2bf(float f) { unsigned u = __builtin_bit_cast(unsigned, f); return (u + 0x7fffu + ((u >> 16) & 1u)) >> 16; }
__device__ __forceinline__ unsigned pk2(float lo, float hi) { return f2bf(lo) | (f2bf(hi) << 16); }
__device__ __forceinline__ float bf2f(unsigned short b) { return __uint_as_float((unsigned)b << 16); }
__device__ __forceinline__ float wave_sum(float v) {
#pragma unroll
    for (int o = 1; o < 64; o <<= 1) v += __shfl_xor(v, o);
    return v;
}
__device__ __forceinline__ float gelu_tanh(float x) { const float z = 0.7978845608028654f * (x + 0.044715f * x * x * x); const float e = __expf(2.0f * z); const float th = 1.0f - 2.0f / (1.0f + e); return 0.5f * x * (1.0f + th); }

#define RLX_AGENT __ATOMIC_RELAXED, __HIP_MEMORY_SCOPE_AGENT
#define XB_TMO      128
#define XB_XCNT(j)  (256  + 64 * (j))
#define XB_XSUB(j)  (1280 + 64 * (j))
#define XB_XGEN(j)  (2304 + 64 * (j))
#define XB_TOP      3328
#define XB_TOPGEN   3392
#define XCD_BAR_WORDS 3456
#define XB_SPIN_CAP (1u << 18)

__device__ __forceinline__ unsigned xb_ld(unsigned* p)              { return __hip_atomic_load(p, __ATOMIC_RELAXED, __HIP_MEMORY_SCOPE_AGENT); }
__device__ __forceinline__ unsigned xb_add(unsigned* p, unsigned v) { return __hip_atomic_fetch_add(p, v, __ATOMIC_RELAXED, __HIP_MEMORY_SCOPE_AGENT); }
__device__ __forceinline__ unsigned xb_xcc_id() { return (unsigned)__builtin_amdgcn_s_getreg((3 << 11) | 20) & 0xFu; }
#define XB_SPIN(cond, bar) do { unsigned _sp = 0; while (cond) { __builtin_amdgcn_s_sleep(1); \
    if ((++_sp & 255u) == 0u) { if (xb_ld(&(bar)[XB_TMO])) break; if (_sp > XB_SPIN_CAP) { atomicAdd(&(bar)[XB_TMO], 1u); break; } } } } while (0)

struct XcdBarrier {
    unsigned* bar; unsigned x;
    volatile LAS unsigned* st;
};

__device__ __forceinline__ XcdBarrier xcd_barrier_post(unsigned* bar, volatile LAS unsigned* st) {
    XcdBarrier b; b.bar = bar; b.x = xb_xcc_id(); b.st = st;
    if (threadIdx.x == 0) { const unsigned old_ = xb_add(&bar[XB_XCNT(b.x)], 1u); st[2] = old_; st[3] = b.x; }
    return b;
}
__device__ __forceinline__ void xcd_barrier_complete(unsigned* bar, unsigned x, unsigned& nloc, unsigned& nx) {
    const unsigned G = gridDim.x * gridDim.y * gridDim.z;
    unsigned sum, cnt, mine, sp = 0u;
    for (;;) {
        sum = 0u; cnt = 0u; mine = 0u;
#pragma unroll
        for (unsigned j = 0; j < 16; ++j) { const unsigned c = xb_ld(&bar[XB_XCNT(j)]); sum += c; cnt += (c > 0u) ? 1u : 0u; mine = (j == x) ? c : mine; }
        if (sum == G) break;
        __builtin_amdgcn_s_sleep(1);
        if ((++sp & 255u) == 0u) { if (xb_ld(&bar[XB_TMO])) break; if (sp > XB_SPIN_CAP) { atomicAdd(&bar[XB_TMO], 1u); break; } }
    }
    nloc = mine > 0u ? mine : 1u; nx = cnt > 0u ? cnt : 1u;
}

__device__ __forceinline__ void xcd_barrier(const XcdBarrier& b) {
    asm volatile("s_waitcnt vmcnt(0)" ::: "memory");
    __syncthreads();
    if (threadIdx.x == 0) {
        unsigned* bar = b.bar;
        __builtin_amdgcn_s_waitcnt(0);
        unsigned nloc = b.st[0], nx = b.st[1];
        if (nloc == 0u) { xcd_barrier_complete(bar, b.x, nloc, nx); b.st[0] = nloc; b.st[1] = nx; }
        const unsigned old = xb_add(&bar[XB_XSUB(b.x)], 1u);
        const unsigned gen = old / nloc;
        if (old + 1u == (gen + 1u) * nloc) {
            __builtin_amdgcn_fence(__ATOMIC_RELEASE, "agent");
            asm volatile("s_waitcnt vmcnt(0)" ::: "memory");
            const unsigned og = xb_add(&bar[XB_TOP], 1u);
            const unsigned tg = og / nx;
            if (og + 1u == (tg + 1u) * nx) xb_add(&bar[XB_TOPGEN], 1u);
            else XB_SPIN(xb_ld(&bar[XB_TOPGEN]) == tg, bar);
            __builtin_amdgcn_fence(__ATOMIC_ACQUIRE, "agent");
            xb_add(&bar[XB_XGEN(b.x)], 1u);
            asm volatile("s_waitcnt vmcnt(0)" ::: "memory");
        } else {
            XB_SPIN(xb_ld(&bar[XB_XGEN(b.x)]) == gen, bar);
            __builtin_amdgcn_fence(__ATOMIC_ACQUIRE, "agent");
            asm volatile("s_waitcnt vmcnt(0)" ::: "memory");
        }
    }
    __syncthreads();
}

struct Frame { LAS unsigned char* lds; int tid, lane, wave, vcu, G; };

__device__ __forceinline__ void p0_transpose_item(const float* W, int K, int N, bf16* WT, LAS float* scr, int item, int lane) {
    const int nblk = N / 32, kb = item / nblk, nb = item % nblk, k0 = 64 * kb, n0 = 32 * nb;
    f32x4 v[8];
#pragma unroll
    for (int i = 0; i < 8; ++i) v[i] = __builtin_nontemporal_load((const f32x4*)(W + (size_t)(k0 + 8 * i + (lane >> 3)) * N + n0 + 4 * (lane & 7)));
#pragma unroll
    for (int i = 0; i < 8; ++i) { LAS float* q = scr + (8 * i + (lane >> 3)) * 33 + 4 * (lane & 7); q[0] = v[i].x; q[1] = v[i].y; q[2] = v[i].z; q[3] = v[i].w; }
    LDS_WAIT(); asm volatile("" ::: "memory");
    const int c = lane & 7;
#pragma unroll
    for (int j = 0; j < 4; ++j) { const int n = (lane >> 3) + 8 * j; const LAS float* s = scr + (8 * c) * 33 + n;
        v4u o; o.x = pk2(s[0 * 33], s[1 * 33]); o.y = pk2(s[2 * 33], s[3 * 33]); o.z = pk2(s[4 * 33], s[5 * 33]); o.w = pk2(s[6 * 33], s[7 * 33]);
        *(GAS v4u*)(WT + (size_t)(n0 + n) * K + k0 + 8 * c) = o; }
    LDS_WAIT(); asm volatile("" ::: "memory");
}
__device__ __forceinline__ void transpose_all(const Frame& F, const float* W, int K, int N, bf16* WT) {
    LAS float* scr = (LAS float*)(F.lds + F.wave * 16384);
    const int gw = F.vcu * NWAVES + F.wave, NGW = F.G * NWAVES, nitems = (K / 64) * (N / 32);
    for (int it = gw; it < nitems; it += NGW) p0_transpose_item(W, K, N, WT, scr, it, F.lane);
}
__device__ __forceinline__ void rms_row_to_bf16(const Frame& F, const float* xrow, const float* g, bf16* orow) {
    const GAS f32x4* xr = (const GAS f32x4*)xrow + F.lane; const GAS f32x4* gr = (const GAS f32x4*)g + F.lane;
    f32x4 v[8]; float s = 0.f;
#pragma unroll
    for (int j = 0; j < 8; ++j) { v[j] = __builtin_nontemporal_load(xr + 64 * j); s += (v[j].x * v[j].x + v[j].y * v[j].y) + (v[j].z * v[j].z + v[j].w * v[j].w); }
    const float rstd = 1.f / sqrtf(wave_sum(s) * (1.f / D) + EPS);
    GAS v2u* o8 = (GAS v2u*)orow + F.lane;
#pragma unroll
    for (int j = 0; j < 8; ++j) { const f32x4 gg = gr[64 * j]; v2u w; w.x = pk2(v[j].x * rstd * gg.x, v[j].y * rstd * gg.y); w.y = pk2(v[j].z * rstd * gg.z, v[j].w * rstd * gg.w); o8[64 * j] = w; }
}

typedef short s16x4 __attribute__((ext_vector_type(4)));
__device__ __forceinline__ s16x4 tr_read16(LAS unsigned char* p) { return __builtin_amdgcn_ds_read_tr16_b64_v4i16((LAS s16x4*)p); }
#define WG_BAR() do { asm volatile("s_waitcnt lgkmcnt(0)" ::: "memory"); __builtin_amdgcn_s_barrier(); asm volatile("" ::: "memory"); } while (0)
struct AUnit { int b, h, d, r, n; bf16* Og; int ldo; float* Lg; };
struct DecP2 { bf16* o2; bf16* o3; float* l2; float* l3;
    __device__ __forceinline__ void operator()(int u, AUnit& a) const { const int bh = u >> 5, sub = u & 31; a.b = bh >> 4; a.h = bh & 15;
        if (sub < 16) { a.d = 4; a.r = sub & 3; a.n = sub >> 2; a.Og = o2; a.ldo = 4096; a.Lg = l2; } else { a.d = 16; a.r = sub - 16; a.n = 0; a.Og = o3; a.ldo = 2048; a.Lg = l3; } } };
struct DecP3 { bf16* y;
    __device__ __forceinline__ void operator()(int u, AUnit& a) const { const int bh = u >> 4; a.b = bh >> 4; a.h = bh & 15; a.d = 1; a.r = 0; a.n = u & 15; a.Og = y; a.ldo = 4096; a.Lg = nullptr; } };
template <bool VSW>
__device__ __forceinline__ void attn_issue(const Frame& F, const bf16* X, const AUnit& a, int ldsoff) {
    const int lane = F.lane, w = F.wave, g = lane >> 4, ql = lane & 15;
#pragma unroll
    for (int i = 0; i < 8; ++i) { const int rg = w + 8 * i, j = 4 * rg + g, jr = j & 15, c = ql ^ (VSW ? (((jr & 7) << 1) | (jr >> 3)) : jr);
        if (i >= 4 || a.n > 0) {
            const size_t go = ((size_t)(a.b * SEQ + ((a.n - 1) * 128 + j) * a.d + a.r) * 2048 + a.h * 128 + c * 8) * 2;
            __builtin_amdgcn_global_load_lds((const unsigned*)((const char*)X + go), (LAS unsigned*)(F.lds + ldsoff + rg * 1024), 16, 0, 0); } }
}
__device__ __forceinline__ void tr_read10(unsigned addr, s16x4 (&f)[10]) {
    asm volatile("ds_read_b64_tr_b16 %0, %10\n\tds_read_b64_tr_b16 %1, %10 offset:4096\n\tds_read_b64_tr_b16 %2, %10 offset:8192\n\tds_read_b64_tr_b16 %3, %10 offset:12288\n\t"
                 "ds_read_b64_tr_b16 %4, %10 offset:16384\n\tds_read_b64_tr_b16 %5, %10 offset:20480\n\tds_read_b64_tr_b16 %6, %10 offset:24576\n\tds_read_b64_tr_b16 %7, %10 offset:28672\n\t"
                 "ds_read_b64_tr_b16 %8, %10 offset:32768\n\tds_read_b64_tr_b16 %9, %10 offset:32768\n\ts_waitcnt lgkmcnt(0)"
                 : "=&v"(f[0]), "=&v"(f[1]), "=&v"(f[2]), "=&v"(f[3]), "=&v"(f[4]), "=&v"(f[5]), "=&v"(f[6]), "=&v"(f[7]), "=&v"(f[8]), "=&v"(f[9]) : "v"(addr) : "memory");
}
__device__ __forceinline__ void tr_issue10(unsigned addr, s16x4 (&f)[10]) {
    asm volatile("ds_read_b64_tr_b16 %0, %10\n\tds_read_b64_tr_b16 %1, %10 offset:4096\n\tds_read_b64_tr_b16 %2, %10 offset:8192\n\tds_read_b64_tr_b16 %3, %10 offset:12288\n\t"
                 "ds_read_b64_tr_b16 %4, %10 offset:16384\n\tds_read_b64_tr_b16 %5, %10 offset:20480\n\tds_read_b64_tr_b16 %6, %10 offset:24576\n\tds_read_b64_tr_b16 %7, %10 offset:28672\n\t"
                 "ds_read_b64_tr_b16 %8, %10 offset:32768\n\tds_read_b64_tr_b16 %9, %10 offset:32768"
                 : "=&v"(f[0]), "=&v"(f[1]), "=&v"(f[2]), "=&v"(f[3]), "=&v"(f[4]), "=&v"(f[5]), "=&v"(f[6]), "=&v"(f[7]), "=&v"(f[8]), "=&v"(f[9]) : "v"(addr) : "memory");
}
template <int N> __device__ __forceinline__ void tr_wait10(s16x4 (&f)[10]) {
    if (N == 10) asm volatile("s_waitcnt lgkmcnt(10)" : "+v"(f[0]), "+v"(f[1]), "+v"(f[2]), "+v"(f[3]), "+v"(f[4]), "+v"(f[5]), "+v"(f[6]), "+v"(f[7]), "+v"(f[8]), "+v"(f[9]) :: "memory");
    else         asm volatile("s_waitcnt lgkmcnt(0)"  : "+v"(f[0]), "+v"(f[1]), "+v"(f[2]), "+v"(f[3]), "+v"(f[4]), "+v"(f[5]), "+v"(f[6]), "+v"(f[7]), "+v"(f[8]), "+v"(f[9]) :: "memory");
}
__device__ __forceinline__ void q_load4(const bf16* p, bf16x8 (&q)[4]) {
    asm volatile("global_load_dwordx4 %0, %4, off\n\tglobal_load_dwordx4 %1, %4, off offset:64\n\tglobal_load_dwordx4 %2, %4, off offset:128\n\tglobal_load_dwordx4 %3, %4, off offset:192"
                 : "=&v"(q[0]), "=&v"(q[1]), "=&v"(q[2]), "=&v"(q[3]) : "v"(p) : "memory");
}
template <int MODE, class Dec>
__device__ __forceinline__ void attn_phase(const Frame& F, const bf16* Q, const bf16* K, const bf16* V, int nunits, const Dec dec, const bf16* O3, const float* L2, const float* L3) {
    const int lane = F.lane, w = F.wave, g = lane >> 4, ql = lane & 15;
    LAS unsigned char* lds = F.lds;
    int u = F.vcu; if (u >= nunits) return;
    AUnit cur, nxt; dec(u, cur); nxt = cur;
    __syncthreads();
    for (int i = F.tid; i < 2048; i += NWAVES * 64) { *(LAS v4u*)(lds + i * 16) = (v4u){0u, 0u, 0u, 0u}; *(LAS v4u*)(lds + 65536 + i * 16) = (v4u){0u, 0u, 0u, 0u}; }
    __syncthreads();
    attn_issue<false>(F, K, cur, 0); attn_issue<true>(F, V, cur, 65536);
    bf16x8 qf[4], qn[4];
    q_load4(Q + (size_t)(cur.b * SEQ + (cur.n * 128 + 16 * w + ql) * cur.d + cur.r) * 2048 + cur.h * 128 + 8 * g, qf);
    asm volatile("s_waitcnt vmcnt(0)" ::: "memory");
#pragma unroll
    for (int ks = 0; ks < 4; ++ks) qn[ks] = qf[ks];
    const LAS unsigned char* kb = lds + (16 * w + ql) * 256;
    unsigned ksw[4];
#pragma unroll
    for (int ks = 0; ks < 4; ++ks) ksw[ks] = (unsigned)(((4 * ks + g) ^ ql) << 4);
    const int q4 = (lane >> 2) & 3, p4 = lane & 3, rl = 4 * g + q4;
    const int frl = ((rl & 7) << 1) | (rl >> 3);
    LAS unsigned char* vb = lds + 65536 + (16 * w + rl) * 256 + 8 * (p4 & 1);
    const float NEG = -INFINITY;
    for (;;) {
        const int un = u + F.G; const bool has_next = un < nunits; if (has_next) dec(un, nxt);
        const int n = cur.n, h = cur.h, d = cur.d;
        const int qi = 16 * w + ql;
        const size_t qrow = (size_t)(cur.b * SEQ + (n * 128 + qi) * d + cur.r);
        WG_BAR();
        const float sl = exp2f(-0.5f * (float)(h + 1)) * LOG2E * (float)d, cb = -sl * (float)(128 + ql - 4 * g);
        f32x4 s[9];
        __builtin_amdgcn_s_setprio(1);
#pragma unroll
        for (int tt = 0; tt < 9; ++tt) {
            s[tt] = (f32x4){fmaf(sl, (float)(16 * tt), cb), fmaf(sl, (float)(16 * tt + 1), cb), fmaf(sl, (float)(16 * tt + 2), cb), fmaf(sl, (float)(16 * tt + 3), cb)};
#pragma unroll
            for (int ks = 0; ks < 4; ++ks) { const bf16x8 a = *(const LAS bf16x8*)(kb + ksw[ks] + tt * 4096); s[tt] = __builtin_amdgcn_mfma_f32_16x16x32_bf16(a, qf[ks], s[tt], 0, 0, 0); }
        }
        __builtin_amdgcn_s_setprio(0);
        WG_BAR();
        v2u a2[8], a3[8]; float l2v = 0.f, l3v = 0.f;
        bf16* op = cur.Og + qrow * (size_t)cur.ldo + h * 128 + 4 * g;
        if (MODE == 1) { const bf16* o3p = O3 + qrow * 2048 + h * 128 + 4 * g;
#pragma unroll
            for (int dt = 0; dt < 8; ++dt) { a2[dt] = *(const v2u*)(op + 16 * dt); a3[dt] = *(const v2u*)(o3p + 16 * dt); }
            l2v = L2[qrow * 16 + h]; l3v = L3[qrow * 16 + h]; }
        if (has_next) { attn_issue<false>(F, K, nxt, 0);
            q_load4(Q + (size_t)(nxt.b * SEQ + (nxt.n * 128 + qi) * nxt.d + nxt.r) * 2048 + nxt.h * 128 + 8 * g, qn); }
#pragma unroll
        for (int e = 0; e < 4; ++e) { if (4 * g + e < ql) s[0][e] = NEG; if (4 * g + e > ql) s[8][e] = NEG; }
        if (n == 0) {
#pragma unroll
            for (int tt = 0; tt < 8; ++tt) { const bool dead = (w + tt < 8);
#pragma unroll
                for (int e = 0; e < 4; ++e) s[tt][e] = dead ? NEG : s[tt][e]; } }
        float mx = NEG;
#pragma unroll
        for (int tt = 0; tt < 9; ++tt) mx = fmaxf(fmaxf(mx, fmaxf(s[tt][0], s[tt][1])), fmaxf(s[tt][2], s[tt][3]));
        mx = fmaxf(mx, __shfl_xor(mx, 16)); mx = fmaxf(mx, __shfl_xor(mx, 32));
        float l = 0.f;
#pragma unroll
        for (int tt = 0; tt < 9; ++tt)
#pragma unroll
            for (int e = 0; e < 4; ++e) { const float p = __builtin_amdgcn_exp2f(s[tt][e] - mx); s[tt][e] = p; l += p; }
        l += __shfl_xor(l, 16); l += __shfl_xor(l, 32);
        bf16x8 pf[5];
#pragma unroll
        for (int pp = 0; pp < 5; ++pp) { const f32x4 px = s[2 * pp], py = (pp < 4) ? s[2 * pp + 1] : (f32x4){0.f, 0.f, 0.f, 0.f};
            v4u u4; u4.x = pg8::cvt_pk_bf16(px[0], px[1]); u4.y = pg8::cvt_pk_bf16(px[2], px[3]); u4.z = pg8::cvt_pk_bf16(py[0], py[1]); u4.w = pg8::cvt_pk_bf16(py[2], py[3]);
            pf[pp] = __builtin_bit_cast(bf16x8, u4); }
        if (has_next) { if (nxt.n > 0) asm volatile("s_waitcnt vmcnt(12)" ::: "memory"); else asm volatile("s_waitcnt vmcnt(8)" ::: "memory"); }
        else asm volatile("s_waitcnt vmcnt(0)" ::: "memory");
        WG_BAR();
        f32x4 o[8];
        s16x4 vfa[10], vfb[10];
        tr_issue10((unsigned)(size_t)(vb + (((p4 >> 1)) ^ frl) * 16), vfa);
#pragma unroll
        for (int dt = 0; dt < 8; dt += 2) {
            tr_issue10((unsigned)(size_t)(vb + (((2 * (dt + 1) + (p4 >> 1)) ^ frl) << 4)), vfb);
            tr_wait10<10>(vfa);
            __builtin_amdgcn_s_setprio(1);
            o[dt] = (f32x4){0.f, 0.f, 0.f, 0.f};
#pragma unroll
            for (int pp = 0; pp < 5; ++pp) { const bf16x8 a = __builtin_shufflevector(vfa[2 * pp], vfa[2 * pp + 1], 0, 1, 2, 3, 4, 5, 6, 7);
                o[dt] = __builtin_amdgcn_mfma_f32_16x16x32_bf16(a, pf[pp], o[dt], 0, 0, 0); }
            __builtin_amdgcn_s_setprio(0);
            if (dt + 2 < 8) { tr_issue10((unsigned)(size_t)(vb + (((2 * (dt + 2) + (p4 >> 1)) ^ frl) << 4)), vfa); tr_wait10<10>(vfb); } else tr_wait10<0>(vfb);
            __builtin_amdgcn_s_setprio(1);
            o[dt + 1] = (f32x4){0.f, 0.f, 0.f, 0.f};
#pragma unroll
            for (int pp = 0; pp < 5; ++pp) { const bf16x8 a = __builtin_shufflevector(vfb[2 * pp], vfb[2 * pp + 1], 0, 1, 2, 3, 4, 5, 6, 7);
                o[dt + 1] = __builtin_amdgcn_mfma_f32_16x16x32_bf16(a, pf[pp], o[dt + 1], 0, 0, 0); }
            __builtin_amdgcn_s_setprio(0);
        }
        WG_BAR();
        asm volatile("s_waitcnt vmcnt(0)" ::: "memory");
        const float linv = 1.0f / l, lse = mx + __builtin_amdgcn_logf(l);
        if (MODE == 0) {
#pragma unroll
            for (int dt = 0; dt < 8; ++dt) { v2u wv; wv.x = pg8::cvt_pk_bf16(o[dt][0] * linv, o[dt][1] * linv); wv.y = pg8::cvt_pk_bf16(o[dt][2] * linv, o[dt][3] * linv); *(v2u*)(op + 16 * dt) = wv; }
            if (g == 0) cur.Lg[qrow * 16 + h] = lse;
        } else {
            const float mm = fmaxf(lse, fmaxf(l2v, l3v));
            float w1 = __builtin_amdgcn_exp2f(lse - mm), w2 = __builtin_amdgcn_exp2f(l2v - mm), w3 = __builtin_amdgcn_exp2f(l3v - mm); const float wi = 1.0f / (w1 + w2 + w3);
            w1 *= wi * linv; w2 *= wi; w3 *= wi;
#pragma unroll
            for (int dt = 0; dt < 8; ++dt) {
                const float y0 = w1 * o[dt][0] + w2 * pg8::bf_lo(a2[dt].x) + w3 * pg8::bf_lo(a3[dt].x), y1 = w1 * o[dt][1] + w2 * pg8::bf_hi(a2[dt].x) + w3 * pg8::bf_hi(a3[dt].x);
                const float y2 = w1 * o[dt][2] + w2 * pg8::bf_lo(a2[dt].y) + w3 * pg8::bf_lo(a3[dt].y), y3 = w1 * o[dt][3] + w2 * pg8::bf_hi(a2[dt].y) + w3 * pg8::bf_hi(a3[dt].y);
                v2u wv; wv.x = pg8::cvt_pk_bf16(y0, y1); wv.y = pg8::cvt_pk_bf16(y2, y3); *(v2u*)(op + 16 * dt) = wv; }
        }
        if (!has_next) break;
        attn_issue<true>(F, V, nxt, 65536);
        cur = nxt; u = un;
#pragma unroll
        for (int ks = 0; ks < 4; ++ks) qf[ks] = qn[ks];
    }
    asm volatile("s_waitcnt vmcnt(0)" ::: "memory");
    __syncthreads();
}

template <int N> __device__ __forceinline__ float row_bcast(float v) {
    return __builtin_bit_cast(float, __builtin_amdgcn_update_dpp(0, __builtin_bit_cast(int, v), 0x150 + N, 0xF, 0xF, false)); }
template <int N> __device__ __forceinline__ float row_shr(float oldv, float v) {
    return __builtin_bit_cast(float, __builtin_amdgcn_update_dpp(__builtin_bit_cast(int, oldv), __builtin_bit_cast(int, v), 0x110 + N, 0xF, 0xF, false)); }
__device__ __forceinline__ float gelu_fast(float x) { const float z = x * (1.0f + 0.044715f * x * x); return x * __builtin_amdgcn_rcpf(1.0f + __builtin_amdgcn_exp2f(-2.0f * 0.7978845608028654f * LOG2E * z)); }

constexpr int LRU_CTAB = 2560, LRU_TOT = 4096, LRU_WFL = 12288, LRU_XBUF = 45056, LRU_XBUF_STRIDE = 36864;
__device__ __forceinline__ void lru_issue_x(const Frame& F, const bf16* XR, int b, int hh, int chunk) {
    const int lane = F.lane, w = F.wave, g = lane >> 4, ql = lane & 15;
#pragma unroll
    for (int i = 0; i < 5; ++i) { const int rg = w + 8 * i;
        if (rg < 33) { const int r = 4 * rg + g; int tok = chunk * 128 - 3 + r; tok = tok < 0 ? 0 : (tok > SEQ - 1 ? SEQ - 1 : tok);
            const size_t go = ((size_t)(b * SEQ + tok) * 2048 + hh * 128 + ((ql ^ (r & 15)) << 3)) * 2;
            __builtin_amdgcn_global_load_lds((const unsigned*)((const char*)XR + go), (LAS unsigned*)(F.lds + LRU_XBUF + (chunk & 1) * LRU_XBUF_STRIDE + rg * 1024), 16, 0, 0); } }
}
__device__ __forceinline__ void lru_item(const Frame& F, const bf16* XR, bf16* XGYL, const float* conv_w, const float* conv_b, const float* wa, const float* ba, const float* wx, const float* bx, const float* lam, int b, int hh, int j2) {
    const int lane = F.lane, w = F.wave, g = lane >> 4, tl = lane & 15;
    LAS float* tab = (LAS float*)F.lds;
    LAS float* ctab = (LAS float*)(F.lds + LRU_CTAB);
    LAS float* tot = (LAS float*)(F.lds + LRU_TOT);
    LAS unsigned char* wfl = F.lds + LRU_WFL;
    __syncthreads();
    for (int i = F.tid; i < 640; i += NWAVES * 64) { const int k = i >> 7, c = i & 127; tab[i] = (k < 4) ? conv_w[k * 2048 + hh * 128 + c] : conv_b[hh * 128 + c]; }
    if (F.tid < 192) { const int k = F.tid >> 6, c = F.tid & 63, ch = hh * 128 + 64 * j2 + c; ctab[F.tid] = (k == 0) ? ba[ch] : (k == 1 ? bx[ch] : 8.0f * log1pf(__expf(-lam[ch]))); }
#pragma unroll
    for (int ff = 0; ff < 4; ++ff) { const int fi = 4 * w + ff, T = fi >> 2, ks = fi & 3;
        const float* p = ((T < 4) ? wa : wx) + (size_t)hh * 16384 + 64 * j2 + 32 * ((T >> 1) & 1) + 8 * (tl >> 2) + 4 * (T & 1) + (tl & 3) + (size_t)(32 * ks + 8 * g) * 128; v4u u4;
        u4.x = pk2(p[0], p[128]); u4.y = pk2(p[256], p[384]); u4.z = pk2(p[512], p[640]); u4.w = pk2(p[768], p[896]);
        *(LAS v4u*)(wfl + (fi * 64 + lane) * 16) = u4; }
    const int chn = hh * 128 + 64 * j2 + 8 * g;
    float hcl = 0.f;
    __syncthreads();
    lru_issue_x(F, XR, b, hh, 0);
    asm volatile("s_waitcnt vmcnt(0)" ::: "memory"); WG_BAR();
    for (int chunk = 0; chunk < 16; ++chunk) {
        if (chunk < 15) lru_issue_x(F, XR, b, hh, chunk + 1);
        const LAS unsigned char* xb = F.lds + LRU_XBUF + (chunk & 1) * LRU_XBUF_STRIDE + (16 * w + tl) * 256;
        const int t = chunk * 128 + 16 * w + tl; const size_t row = (size_t)b * SEQ + t;
        bf16* yp = XGYL + row * 4096 + chn;
        const v4u gv0 = *(const v4u*)yp, gv1 = *(const v4u*)(yp + 32);
        bf16x8 bfr[4]; float xcf[16];
#pragma unroll
        for (int i = 0; i < 16; ++i) xcf[i] = 0.f;
#pragma unroll
        for (int ks = 0; ks < 4; ++ks) { const int cl = 32 * ks + 8 * g; float a8[8];
            { const f32x4 b0 = *(const LAS f32x4*)(tab + 512 + cl), b1 = *(const LAS f32x4*)(tab + 512 + cl + 4); a8[0] = b0[0]; a8[1] = b0[1]; a8[2] = b0[2]; a8[3] = b0[3]; a8[4] = b1[0]; a8[5] = b1[1]; a8[6] = b1[2]; a8[7] = b1[3]; }
#pragma unroll
            for (int k = 0; k < 4; ++k) { const int rr = 16 * w + tl + k; v4u xq = *(const LAS v4u*)(xb + k * 256 + (((4 * ks + g) ^ (rr & 15)) << 4));
                const bool inb = (chunk > 0) || (rr >= 3); xq.x = inb ? xq.x : 0u; xq.y = inb ? xq.y : 0u; xq.z = inb ? xq.z : 0u; xq.w = inb ? xq.w : 0u;
                const f32x4 w0 = *(const LAS f32x4*)(tab + k * 128 + cl), w1 = *(const LAS f32x4*)(tab + k * 128 + cl + 4);
                a8[0] += w0[0] * pg8::bf_lo(xq.x); a8[1] += w0[1] * pg8::bf_hi(xq.x); a8[2] += w0[2] * pg8::bf_lo(xq.y); a8[3] += w0[3] * pg8::bf_hi(xq.y);
                a8[4] += w1[0] * pg8::bf_lo(xq.z); a8[5] += w1[1] * pg8::bf_hi(xq.z); a8[6] += w1[2] * pg8::bf_lo(xq.w); a8[7] += w1[3] * pg8::bf_hi(xq.w); }
            v4u u4; u4.x = pg8::cvt_pk_bf16(a8[0], a8[1]); u4.y = pg8::cvt_pk_bf16(a8[2], a8[3]); u4.z = pg8::cvt_pk_bf16(a8[4], a8[5]); u4.w = pg8::cvt_pk_bf16(a8[6], a8[7]); bfr[ks] = __builtin_bit_cast(bf16x8, u4);
#pragma unroll
            for (int i = 0; i < 8; ++i) { xcf[i] = (ks == 2 * j2) ? a8[i] : xcf[i]; xcf[8 + i] = (ks == 2 * j2 + 1) ? a8[i] : xcf[8 + i]; } }
        f32x4 pa[8];
#pragma unroll
        for (int T = 0; T < 8; ++T) { pa[T] = (f32x4){0.f, 0.f, 0.f, 0.f};
#pragma unroll
            for (int ks = 0; ks < 4; ++ks) { const bf16x8 wfr = *(const LAS bf16x8*)(wfl + ((T * 4 + ks) * 64 + lane) * 16); pa[T] = __builtin_amdgcn_mfma_f32_16x16x32_bf16(wfr, bfr[ks], pa[T], 0, 0, 0); } }
        float av[16], uv[16];
#pragma unroll
        for (int s2 = 0; s2 < 2; ++s2) {
            const f32x4 ba0 = *(const LAS f32x4*)(ctab + 32 * s2 + 8 * g), ba1 = *(const LAS f32x4*)(ctab + 32 * s2 + 8 * g + 4);
            const f32x4 bx0 = *(const LAS f32x4*)(ctab + 64 + 32 * s2 + 8 * g), bx1 = *(const LAS f32x4*)(ctab + 64 + 32 * s2 + 8 * g + 4);
            const f32x4 sp0 = *(const LAS f32x4*)(ctab + 128 + 32 * s2 + 8 * g), sp1 = *(const LAS f32x4*)(ctab + 128 + 32 * s2 + 8 * g + 4);
#pragma unroll
            for (int i = 0; i < 8; ++i) { const float bai = (i < 4) ? ba0[i & 3] : ba1[i & 3], bxi = (i < 4) ? bx0[i & 3] : bx1[i & 3], spi = (i < 4) ? sp0[i & 3] : sp1[i & 3];
                const float rp = pa[s2 * 2 + (i >> 2)][i & 3] + bai, xp = pa[4 + s2 * 2 + (i >> 2)][i & 3] + bxi;
                const float rr = pg8::fsigmoid(rp), ig = pg8::fsigmoid(xp), la = -spi * rr, x2 = 2.0f * la;
                const float a = __builtin_amdgcn_exp2f(LOG2E * la);
                const float em1 = (x2 > -0.3f) ? x2 * (1.0f + x2 * (0.5f + x2 * (0.16666667f + x2 * (0.041666668f + x2 * 0.0083333333f)))) : (a * a - 1.0f);
                av[8 * s2 + i] = a; uv[8 * s2 + i] = __builtin_amdgcn_sqrtf(-em1) * ig * xcf[8 * s2 + i]; } }
#pragma unroll
        for (int i = 0; i < 16; ++i) {
            { const float ap = row_shr<1>(1.0f, av[i]), up = row_shr<1>(0.0f, uv[i]); uv[i] = fmaf(av[i], up, uv[i]); av[i] *= ap; }
            { const float ap = row_shr<2>(1.0f, av[i]), up = row_shr<2>(0.0f, uv[i]); uv[i] = fmaf(av[i], up, uv[i]); av[i] *= ap; }
            { const float ap = row_shr<4>(1.0f, av[i]), up = row_shr<4>(0.0f, uv[i]); uv[i] = fmaf(av[i], up, uv[i]); av[i] *= ap; }
            { const float ap = row_shr<8>(1.0f, av[i]), up = row_shr<8>(0.0f, uv[i]); uv[i] = fmaf(av[i], up, uv[i]); av[i] *= ap; } }
        LAS float* tb = tot + (chunk & 1) * 1024;
        if (tl == 15) {
#pragma unroll
            for (int i = 0; i < 16; i += 2) *(LAS f32x4*)(tb + (w * 64 + g * 16 + i) * 2) = (f32x4){av[i], uv[i], av[i + 1], uv[i + 1]}; }
        asm volatile("s_waitcnt vmcnt(0)" ::: "memory"); WG_BAR();
        float myh = 0.f;
#pragma unroll
        for (int w2 = 0; w2 < 8; ++w2) { const pg8::f32x2 au = *(const LAS pg8::f32x2*)(tb + (w2 * 64 + g * 16 + tl) * 2);
            myh = (w2 == w) ? hcl : myh; hcl = fmaf(au[0], hcl, au[1]); }
        float y[16];
        y[0] = row_bcast<0>(myh); y[1] = row_bcast<1>(myh); y[2] = row_bcast<2>(myh); y[3] = row_bcast<3>(myh); y[4] = row_bcast<4>(myh); y[5] = row_bcast<5>(myh); y[6] = row_bcast<6>(myh); y[7] = row_bcast<7>(myh);
        y[8] = row_bcast<8>(myh); y[9] = row_bcast<9>(myh); y[10] = row_bcast<10>(myh); y[11] = row_bcast<11>(myh); y[12] = row_bcast<12>(myh); y[13] = row_bcast<13>(myh); y[14] = row_bcast<14>(myh); y[15] = row_bcast<15>(myh);
#pragma unroll
        for (int i = 0; i < 16; ++i) y[i] = av[i] * y[i] + uv[i];
        y[0] *= pg8::bf_lo(gv0.x); y[1] *= pg8::bf_hi(gv0.x); y[2] *= pg8::bf_lo(gv0.y); y[3] *= pg8::bf_hi(gv0.y); y[4] *= pg8::bf_lo(gv0.z); y[5] *= pg8::bf_hi(gv0.z); y[6] *= pg8::bf_lo(gv0.w); y[7] *= pg8::bf_hi(gv0.w);
        y[8] *= pg8::bf_lo(gv1.x); y[9] *= pg8::bf_hi(gv1.x); y[10] *= pg8::bf_lo(gv1.y); y[11] *= pg8::bf_hi(gv1.y); y[12] *= pg8::bf_lo(gv1.z); y[13] *= pg8::bf_hi(gv1.z); y[14] *= pg8::bf_lo(gv1.w); y[15] *= pg8::bf_hi(gv1.w);
        v4u o0, o1; o0.x = pg8::cvt_pk_bf16(y[0], y[1]); o0.y = pg8::cvt_pk_bf16(y[2], y[3]); o0.z = pg8::cvt_pk_bf16(y[4], y[5]); o0.w = pg8::cvt_pk_bf16(y[6], y[7]);
        o1.x = pg8::cvt_pk_bf16(y[8], y[9]); o1.y = pg8::cvt_pk_bf16(y[10], y[11]); o1.z = pg8::cvt_pk_bf16(y[12], y[13]); o1.w = pg8::cvt_pk_bf16(y[14], y[15]);
        *(v4u*)yp = o0; *(v4u*)(yp + 32) = o1;
    }
}

struct Args { const float* in[17]; float* out; unsigned char* ws; int ph_lo, ph_hi; };

__global__ void __launch_bounds__(NWAVES * 64, 2) mega(Args args) {
    extern __shared__ __attribute__((aligned(16))) unsigned char lds[];
    Frame F;
    F.lds = (LAS unsigned char*)lds;
    F.tid = threadIdx.x; F.lane = F.tid & 63; F.wave = __builtin_amdgcn_readfirstlane(F.tid >> 6);
    F.G = gridDim.x; { const int bx = blockIdx.x; F.vcu = (F.G % 8 == 0) ? (bx % 8) * (F.G / 8) + bx / 8 : bx; }
    unsigned char* ws = args.ws; unsigned char* dout = (unsigned char*)args.out;
    const float* x = args.in[0];
    const int lo = args.ph_lo, hi = args.ph_hi;
    volatile LAS unsigned* MISC = (volatile LAS unsigned*)(F.lds + MISC_OFF);
    if (F.tid < 32) MISC[F.tid] = 0u;
    __syncthreads();
    XcdBarrier bar; bar.bar = (unsigned*)(ws + WS_CTL) + CW_BAR; bar.x = 0; bar.st = nullptr;
    if (hi - lo > 1) bar = xcd_barrier_post((unsigned*)(ws + WS_CTL) + CW_BAR, MISC + 8);
    if (hi > 1000) cg::this_grid().sync();
#define IN(k) (lo <= (k) && (k) < hi)
#define SYNC(k) do { if (IN(k) && IN((k) + 1)) { xcd_barrier(bar); } } while (0)
    const int gw = F.vcu * NWAVES + F.wave, NGW = F.G * NWAVES;
    bf16* XNL = (bf16*)dout;
    bf16* XGR = (bf16*)dout + 2048;

    if (IN(0)) {
        for (int i = blockIdx.x * 512 + F.tid; i < 2 * M; i += F.G * 512) ((float*)(ws + WS_RSS1))[i] = 0.f;
        transpose_all(F, args.in[2], D, INC, (bf16*)(ws + WS_WIN));
        transpose_all(F, args.in[10], D, D, (bf16*)(ws + WS_WPA));
        transpose_all(F, args.in[11], D, D, (bf16*)(ws + WS_WPL));
        transpose_all(F, args.in[12], D, D, (bf16*)(ws + WS_WOUT));
        transpose_all(F, args.in[14], D, FF, (bf16*)(ws + WS_WUP));
        for (int m = gw; m < M; m += NGW) rms_row_to_bf16(F, x + (size_t)m * D, args.in[1], XNL + (size_t)m * 4096);
    }
    SYNC(0);
    int ceff = (int)blockIdx.x;
    if (IN(0) && IN(1)) {
        if (F.tid == 0) { unsigned okk = (F.G % 8 == 0) ? 1u : 0u;
            for (unsigned j = 0; j < 16; ++j) { const unsigned c = xb_ld(&bar.bar[XB_XCNT(j)]); okk &= (c == (j < 8 ? (unsigned)F.G / 8u : 0u)) ? 1u : 0u; }
            MISC[12] = okk; }
        __syncthreads();
        if (MISC[12] != 0u) { const int xid = (int)MISC[11], loc = (int)MISC[10]; ceff = xid + 8 * loc; F.vcu = xid * (F.G / 8) + loc; }
    }
    if (IN(1)) {
        pg8::Gemm g{XNL, (const bf16*)(ws + WS_WIN), M, INC, D, 4096}; pg8::StaticOrder S; S.init(M, INC, F.G, ceff);
        pg8::EpiProj E{(bf16*)(ws + WS_Q), XGR, (bf16*)(ws + WS_GA), QSCALE};
        pg8::gemm_phase<pg8::EpiProj, pg8::StaticOrder, PG8_ALIGN, PG8_SP2>(F.lds, g, S, E);
    }
    SYNC(1);
    if (IN(2)) {
#if !USE_NAIVE_LRU
        for (int it = F.vcu; it < 256; it += F.G) lru_item(F, (const bf16*)(ws + WS_XR), XGR, args.in[3], args.in[4], args.in[5], args.in[6], args.in[7], args.in[8], args.in[9], it >> 5, (it >> 1) & 15, it & 1);
#endif
#if !USE_NAIVE_ATTN
        { const DecP2 dec{XNL, (bf16*)(ws + WS_O3), (float*)(ws + WS_LSE2), (float*)(ws + WS_LSE3)};
          attn_phase<0, DecP2>(F, (const bf16*)(ws + WS_Q), (const bf16*)(ws + WS_K), (const bf16*)(ws + WS_V), 4096, dec, nullptr, nullptr, nullptr); }
#endif
    }
    SYNC(2);
    if (IN(3)) {
#if !USE_NAIVE_ATTN
        { const DecP3 dec{XNL};
          attn_phase<1, DecP3>(F, (const bf16*)(ws + WS_Q), (const bf16*)(ws + WS_K), (const bf16*)(ws + WS_V), 2048, dec, (const bf16*)(ws + WS_O3), (const float*)(ws + WS_LSE2), (const float*)(ws + WS_LSE3)); }
#endif
    }
    SYNC(3);
    if (IN(4)) {
        transpose_all(F, args.in[15], FF, D, (bf16*)(ws + WS_WDN));
        __syncthreads();
        { pg8::Gemm g{XNL, (const bf16*)(ws + WS_WPA), M, D, D, 4096}; pg8::StaticOrder S; S.init(M, D, F.G, ceff);
          pg8::EpiGate<0> E{(const bf16*)(ws + WS_GA), (bf16*)(ws + WS_MRG)};
          pg8::gemm_phase<pg8::EpiGate<0>, pg8::StaticOrder, PG8_ALIGN, PG8_SP2>(F.lds, g, S, E); }
        VM_WAIT(); __syncthreads();
        { pg8::Gemm g{XGR, (const bf16*)(ws + WS_WPL), M, D, D, 4096}; pg8::StaticOrder S; S.init(M, D, F.G, ceff);
          pg8::EpiGate<1> E{(const bf16*)(ws + WS_GL), (bf16*)(ws + WS_MRG)};
          pg8::gemm_phase<pg8::EpiGate<1>, pg8::StaticOrder, PG8_ALIGN, PG8_SP2>(F.lds, g, S, E); }
    }
    SYNC(4);
    if (IN(5)) {
        pg8::Gemm g{(const bf16*)(ws + WS_MRG), (const bf16*)(ws + WS_WOUT), M, D, D, D}; pg8::StaticOrder S; S.init(M, D, F.G, ceff);
        pg8::EpiRes<true> E{x, args.out, (bf16*)(ws + WS_A5), args.in[13], (float*)(ws + WS_RSS1)};
        pg8::gemm_phase<pg8::EpiRes<true>, pg8::StaticOrder, PG8_ALIGN, PG8_SP2>(F.lds, g, S, E);
    }
    SYNC(5);
    if (IN(6)) {
        pg8::Gemm g{(const bf16*)(ws + WS_A5), (const bf16*)(ws + WS_WUP), M, FF, D, D}; pg8::StaticOrder S; S.init(M, FF, F.G, ceff);
        pg8::EpiUp E{(const float*)(ws + WS_RSS1), (bf16*)(ws + WS_HID)};
        pg8::gemm_phase<pg8::EpiUp, pg8::StaticOrder, PG8_ALIGN, PG8_SP2>(F.lds, g, S, E);
    }
    SYNC(6);
    if (IN(7)) {
        pg8::Gemm g{(const bf16*)(ws + WS_HID), (const bf16*)(ws + WS_WDN), M, D, FF, FF}; pg8::StaticOrder S; S.init(M, D, F.G, ceff);
        pg8::EpiRes<false> E{args.out, args.out, nullptr, nullptr, (float*)(ws + WS_RSS2)};
        pg8::gemm_phase<pg8::EpiRes<false>, pg8::StaticOrder, PG8_ALIGN, PG8_SP2>(F.lds, g, S, E);
    }
    SYNC(7);
    if (IN(8)) {
        const float* rss = (const float*)(ws + WS_RSS2); const GAS f32x4* gr = (const GAS f32x4*)args.in[16] + F.lane;
        for (int m = gw; m < M; m += NGW) { const float rstd = 1.f / sqrtf(rss[m] * (1.f / D) + EPS); GAS f32x4* o = (GAS f32x4*)(args.out + (size_t)m * D) + F.lane;
#pragma unroll
            for (int j = 0; j < 8; ++j) { const f32x4 gg = gr[64 * j]; f32x4 v = o[64 * j]; v = v * rstd; v.x *= gg.x; v.y *= gg.y; v.z *= gg.z; v.w *= gg.w; o[64 * j] = v; } }
    }
#undef IN
#undef SYNC
}

extern "C" void kernel_launch(void* const* d_in, const int* in_sizes, int n_in, void* d_out, int out_size, void* d_ws, size_t ws_size, hipStream_t stream) {
    static int grid = 0;
    if (grid == 0) {
        if (n_in != 17 || out_size != M * D || ws_size < WS_END) { fprintf(stderr, "kernel_launch: unexpected shapes: n_in %d out %d ws %zu\n", n_in, out_size, ws_size); grid = -1; return; }
        int dev = 0, cus = 0;
        hipGetDevice(&dev); hipDeviceGetAttribute(&cus, hipDeviceAttributeMultiprocessorCount, dev);
        hipFuncSetAttribute((const void*)mega, hipFuncAttributeMaxDynamicSharedMemorySize, LDS_BYTES);
        grid = cus > 0 ? cus : 256;
    }
    if (grid < 0) return;
    Args a{};
    for (int i = 0; i < 17; ++i) a.in[i] = (const float*)d_in[i];
    a.out = (float*)d_out; a.ws = (unsigned char*)d_ws;
    unsigned char* ws = (unsigned char*)d_ws;
#if ONE_LAUNCH
    a.ph_lo = 0; a.ph_hi = 9;
    if (hipMemsetAsync((char*)d_ws + WS_CTL, 0, CTL_ZERO_BYTES, stream) != hipSuccess) { fprintf(stderr, "memset of control words failed\n"); return; }
    void* kargs[] = {&a};
    hipError_t e = hipLaunchCooperativeKernel((const void*)mega, dim3(grid), dim3(NWAVES * 64), kargs, LDS_BYTES, stream);
    if (e != hipSuccess) fprintf(stderr, "cooperative launch failed: %s (grid %d)\n", hipGetErrorString(e), grid);
#else
    auto launch = [&](int lo, int hi) { a.ph_lo = lo; a.ph_hi = hi; hipLaunchKernelGGL(mega, dim3(grid), dim3(NWAVES * 64), LDS_BYTES, stream, a); };
    launch(0, 1); launch(1, 2); launch(2, 3);
    launch(3, 4);
    launch(4, 5); launch(5, 6); launch(6, 7); launch(7, 8); launch(8, 9);
#endif
}
```
